# Optimizing an MI355X kernel written in HIP

```python
import jax, jax.numpy as jnp
from jax import lax
import numpy as np

D_MODEL = 2048
BATCH = 2
SEQ = 16384
DEPTH = 1

GRID_W = 64
CTX_LEN = 256
HEAD_DIM = 128
GDN_HEADS = 8
ATTN_HEADS = 8
KV_HEADS = 2
GQA_GROUP = ATTN_HEADS // KV_HEADS
GDN_WIDTH = GDN_HEADS * HEAD_DIM
ATTN_WIDTH = ATTN_HEADS * HEAD_DIM
KV_WIDTH = KV_HEADS * HEAD_DIM
MIX_WIDTH = GDN_WIDTH + ATTN_WIDTH
IN_COLS = 3 * GDN_WIDTH + GDN_WIDTH + 4 * GDN_HEADS + ATTN_WIDTH + 2 * KV_WIDTH + ATTN_WIDTH
CONV_K = 5
CHUNK = 64
Q_BLOCK = 128
ROPE_THETA = 10000.0
ROPE_HALF = HEAD_DIM // 4
EPS = 1e-6

kernel_name = 'hymba_style_gdn_gqa_diffusion_block'


def rms_norm(x, w):
    xf = x.astype(jnp.float32)
    y = xf * lax.rsqrt(jnp.mean(xf * xf, axis=-1, keepdims=True) + EPS)
    return (y * w.astype(jnp.float32)).astype(x.dtype)


def l2_norm(x):
    return x * lax.rsqrt(jnp.sum(x * x, axis=-1, keepdims=True) + EPS)


def split_proj(p):
    sizes = (3 * GDN_WIDTH, GDN_WIDTH, 4 * GDN_HEADS, ATTN_WIDTH, KV_WIDTH, KV_WIDTH, ATTN_WIDTH)
    idx = [int(i) for i in np.cumsum(sizes)[:-1]]
    return jnp.split(p, idx, axis=-1)


def centred_conv(x, w):
    pad = CONV_K // 2
    L = x.shape[1]
    xp = jnp.pad(x, ((0, 0), (pad, pad), (0, 0)))
    out = xp[:, 0:L] * w[0]
    for j in range(1, CONV_K):
        out = out + xp[:, j:j + L] * w[j]
    return out


def axial_rope_tables(L):
    rows_n = L // GRID_W
    row = jnp.repeat(jnp.arange(rows_n, dtype=jnp.int32), GRID_W).astype(jnp.float32)
    col = jnp.tile(jnp.arange(GRID_W, dtype=jnp.int32), rows_n).astype(jnp.float32)
    inv = ROPE_THETA ** (-jnp.arange(ROPE_HALF, dtype=jnp.float32) / ROPE_HALF)
    ang = jnp.stack([row[:, None] * inv, col[:, None] * inv], axis=1)
    return jnp.cos(ang), jnp.sin(ang)


def apply_rope(x, cos, sin):
    B, L, H, _ = x.shape
    xr = x.astype(jnp.float32).reshape(B, L, H, 2, 2, ROPE_HALF)
    x1, x2 = xr[..., 0, :], xr[..., 1, :]
    c = cos[None, :, None]
    s = sin[None, :, None]
    out = jnp.stack([x1 * c - x2 * s, x2 * c + x1 * s], axis=-2)
    return out.reshape(B, L, H, HEAD_DIM).astype(x.dtype)


def chunk_gated_delta(q, k, v, g, beta, s0):
    B, L, H, DK = q.shape
    DV = v.shape[-1]
    n = L // CHUNK

    def chunks(t):
        return t.reshape(B, n, CHUNK, H, -1).transpose(1, 0, 3, 2, 4)

    q_c, k_c, v_c = chunks(q), chunks(k), chunks(v)
    g_c = jnp.cumsum(g.reshape(B, n, CHUNK, H).transpose(1, 0, 3, 2), axis=-1)
    b_c = beta.reshape(B, n, CHUNK, H).transpose(1, 0, 3, 2)[..., None]
    incl = jnp.tril(jnp.ones((CHUNK, CHUNK), dtype=bool))
    strict = jnp.tril(jnp.ones((CHUNK, CHUNK), dtype=bool), -1)
    diff = g_c[..., :, None] - g_c[..., None, :]
    decay = jnp.where(incl, jnp.exp(jnp.where(incl, diff, 0.0)), 0.0)
    k_beta = k_c * b_c
    a = jnp.where(strict, jnp.einsum('nbhid,nbhjd->nbhij', k_beta, k_c) * decay, 0.0)
    eye = jnp.eye(CHUNK, dtype=q.dtype)
    t_inv = lax.linalg.triangular_solve(eye + a, jnp.broadcast_to(eye, a.shape),
                                        left_side=True, lower=True)
    u = jnp.einsum('nbhij,nbhjd->nbhid', t_inv, v_c * b_c)
    w = jnp.einsum('nbhij,nbhjd->nbhid', t_inv, k_beta * jnp.exp(g_c)[..., None])
    intra = jnp.where(incl, jnp.einsum('nbhid,nbhjd->nbhij', q_c, k_c) * decay, 0.0)

    def step(s, inp):
        q_i, k_i, u_i, w_i, g_i, intra_i = inp
        v_new = u_i - jnp.einsum('bhcd,bhde->bhce', w_i, s)
        o_i = (jnp.einsum('bhcd,bhde->bhce', q_i * jnp.exp(g_i)[..., None], s)
               + jnp.einsum('bhij,bhje->bhie', intra_i, v_new))
        g_last = g_i[..., -1:]
        s = (s * jnp.exp(g_last)[..., None]
             + jnp.einsum('bhcd,bhce->bhde', k_i * jnp.exp(g_last - g_i)[..., None], v_new))
        return s, o_i

    s_final, o = lax.scan(step, s0, (q_c, k_c, u, w, g_c, intra))
    return o.transpose(1, 0, 3, 2, 4).reshape(B, L, H, DV), s_final


def gdn_inputs(qkv, gates, conv_w, a_log, dt_bias):
    B, L, _ = qkv.shape
    qkv = jax.nn.silu(centred_conv(qkv, conv_w)).astype(jnp.float32)
    q, k, v = jnp.split(qkv.reshape(B, L, 3, GDN_HEADS, HEAD_DIM), 3, axis=2)
    q = l2_norm(q[:, :, 0]) * (HEAD_DIM ** -0.5)
    k = l2_norm(k[:, :, 0])
    v = v[:, :, 0]
    gates = gates.astype(jnp.float32).reshape(B, L, 2, 2, GDN_HEADS)
    beta = jax.nn.sigmoid(jnp.moveaxis(gates[:, :, 0], 2, 0))
    a_lg = a_log.astype(jnp.float32)[:, None, None, :]
    dtb = dt_bias.astype(jnp.float32)[:, None, None, :]
    g = -jnp.exp(a_lg) * jax.nn.softplus(jnp.moveaxis(gates[:, :, 1], 2, 0) + dtb)
    return q, k, v, beta, g


def flip(t):
    return t[:, ::-1]


def attn_heads(q, k, v, q_norm_w, k_norm_w):
    B, L, _ = q.shape
    q = rms_norm(q.reshape(B, L, ATTN_HEADS, HEAD_DIM), q_norm_w)
    k = rms_norm(k.reshape(B, L, KV_HEADS, HEAD_DIM), k_norm_w)
    v = v.reshape(B, L, KV_HEADS, HEAD_DIM)
    return q, k, v


def attend(q_blk, k_all, v_all):
    s = jnp.einsum('bqkgd,bskd->bkgqs', q_blk, k_all).astype(jnp.float32) * (HEAD_DIM ** -0.5)
    p = jax.nn.softmax(s, axis=-1).astype(v_all.dtype)
    return jnp.einsum('bkgqs,bskd->bqkgd', p, v_all)


def block_attention(q, k_all, v_all):
    B, L, _, _ = q.shape
    nb = L // Q_BLOCK
    qb = q.reshape(B, nb, Q_BLOCK, KV_HEADS, GQA_GROUP, HEAD_DIM).transpose(1, 0, 2, 3, 4, 5)
    o = lax.map(lambda blk: attend(blk, k_all, v_all), qb)
    return o.transpose(1, 0, 2, 3, 4, 5).reshape(B, L, ATTN_WIDTH)


def mixer(h, hc, w_in, conv_w, a_log, dt_bias, gdn_norm_w, q_norm_w, k_norm_w, w_out,
          cos, sin, with_ctx):
    B, L, _ = h.shape
    Lc = hc.shape[1]
    qkv_g, z_g, gates, q_a, k_a, v_a, z_a = split_proj(h @ w_in)
    qkv_gc, z_gc, gates_c, q_ac, k_ac, v_ac, z_ac = split_proj(hc @ w_in)

    ql, kl, vl, bl, gl = gdn_inputs(qkv_g, gates, conv_w, a_log, dt_bias)
    qc, kc, vc, bc, gc = gdn_inputs(qkv_gc, gates_c, conv_w, a_log, dt_bias)
    s0 = jnp.zeros((B, GDN_HEADS, HEAD_DIM, HEAD_DIM), jnp.float32)
    o_cf, s_cf = chunk_gated_delta(qc, kc, vc, gc[0], bc[0], s0)
    o_lf, _ = chunk_gated_delta(ql, kl, vl, gl[0], bl[0], s_cf)
    o_cb, s_cb = chunk_gated_delta(flip(qc), flip(kc), flip(vc), flip(gc[1]), flip(bc[1]), s0)
    o_lb, _ = chunk_gated_delta(flip(ql), flip(kl), flip(vl), flip(gl[1]), flip(bl[1]), s_cb)
    o_gdn = (o_lf + flip(o_lb)).astype(h.dtype)
    gdn_lat = (rms_norm(o_gdn, gdn_norm_w).reshape(B, L, GDN_WIDTH) * jax.nn.silu(z_g))

    qa, ka, va = attn_heads(q_a, k_a, v_a, q_norm_w, k_norm_w)
    qa, ka = apply_rope(qa, cos, sin), apply_rope(ka, cos, sin)
    qac, kac, vac = attn_heads(q_ac, k_ac, v_ac, q_norm_w, k_norm_w)
    k_all = jnp.concatenate([kac, ka], axis=1)
    v_all = jnp.concatenate([vac, va], axis=1)
    attn_lat = block_attention(qa, k_all, v_all) * jax.nn.silu(z_a)

    y = jnp.concatenate([gdn_lat, attn_lat], axis=-1) @ w_out
    if not with_ctx:
        return y, None
    o_gdn_c = (o_cf + flip(o_cb)).astype(hc.dtype)
    gdn_ctx = rms_norm(o_gdn_c, gdn_norm_w).reshape(B, Lc, GDN_WIDTH) * jax.nn.silu(z_gc)
    qcb = qac.reshape(B, Lc, KV_HEADS, GQA_GROUP, HEAD_DIM)
    attn_ctx = attend(qcb, kac, vac).reshape(B, Lc, ATTN_WIDTH) * jax.nn.silu(z_ac)
    yc = jnp.concatenate([gdn_ctx, attn_ctx], axis=-1) @ w_out
    return y, yc


def setup_inputs(seed: int = 0) -> dict:
    key = jax.random.key(seed)
    ks = jax.random.split(key, 16)
    nrm = jax.random.normal
    dt = jnp.exp(jax.random.uniform(ks[10], (DEPTH, 2, GDN_HEADS), minval=np.log(1e-3), maxval=np.log(1e-1)))
    return {
        'x': nrm(ks[0], (BATCH, SEQ, D_MODEL), jnp.float32),
        'c': nrm(ks[1], (BATCH, D_MODEL), jnp.float32),
        'ctx': nrm(ks[2], (BATCH, CTX_LEN, D_MODEL), jnp.float32),
        'c_ctx': nrm(ks[3], (D_MODEL,), jnp.float32),
        'w_ada': nrm(ks[4], (DEPTH, D_MODEL, 3 * D_MODEL), jnp.float32) * D_MODEL ** -0.5,
        'b_ada': nrm(ks[5], (DEPTH, 3 * D_MODEL), jnp.float32) * 0.02,
        'norm_w': 1.0 + 0.02 * nrm(ks[6], (DEPTH, D_MODEL), jnp.float32),
        'w_in': nrm(ks[7], (DEPTH, D_MODEL, IN_COLS), jnp.float32) * D_MODEL ** -0.5,
        'conv_w': nrm(ks[8], (DEPTH, CONV_K, 3 * GDN_WIDTH), jnp.float32) * CONV_K ** -0.5,
        'a_log': jnp.log(jax.random.uniform(ks[9], (DEPTH, 2, GDN_HEADS), minval=1.0, maxval=16.0)),
        'dt_bias': dt + jnp.log(-jnp.expm1(-dt)),
        'gdn_norm_w': 1.0 + 0.02 * nrm(ks[11], (DEPTH, HEAD_DIM), jnp.float32),
        'q_norm_w': 1.0 + 0.02 * nrm(ks[12], (DEPTH, HEAD_DIM), jnp.float32),
        'k_norm_w': 1.0 + 0.02 * nrm(ks[13], (DEPTH, HEAD_DIM), jnp.float32),
        'w_out': nrm(ks[14], (DEPTH, MIX_WIDTH, D_MODEL), jnp.float32) * MIX_WIDTH ** -0.5,
        'final_norm_w': 1.0 + 0.02 * nrm(ks[15], (D_MODEL,), jnp.float32),
    }


def reference(x, c, ctx, c_ctx, w_ada, b_ada, norm_w, w_in, conv_w, a_log, dt_bias,
              gdn_norm_w, q_norm_w, k_norm_w, w_out, final_norm_w):
    cos, sin = axial_rope_tables(x.shape[1])
    for l in range(DEPTH):
        mod = jax.nn.silu(c) @ w_ada[l] + b_ada[l]
        shift, scale, gate = [m[:, None, :] for m in jnp.split(mod, 3, axis=-1)]
        mod_c = jax.nn.silu(c_ctx) @ w_ada[l] + b_ada[l]
        shift_c, scale_c, gate_c = jnp.split(mod_c, 3, axis=-1)
        h = rms_norm(x, norm_w[l]) * (1.0 + scale) + shift
        hc = rms_norm(ctx, norm_w[l]) * (1.0 + scale_c) + shift_c
        with_ctx = l < DEPTH - 1
        y, yc = mixer(h, hc, w_in[l], conv_w[l], a_log[l], dt_bias[l], gdn_norm_w[l],
                      q_norm_w[l], k_norm_w[l], w_out[l], cos, sin, with_ctx)
        x = x + gate * y
        if with_ctx:
            ctx = ctx + gate_c * yc
    return rms_norm(x, final_norm_w)
```

```cpp
#include <hip/hip_runtime.h>
#include <hip/hip_bf16.h>
#include <hip/hip_cooperative_groups.h>
#include <cstdio>
#include <cstdint>
namespace cg = cooperative_groups;

#ifndef MK_COOP
#define MK_COOP 1
#endif

constexpr int DM = 2048, NB = 2, SEQ = 16384, CTXL = 256, TOK = SEQ + CTXL, MROWS = NB * TOK;
constexpr int HD = 128, GH = 8, NCH = TOK / 64;
constexpr int INC = 6688, NPAD = 6912;
constexpr float EPSF = 1e-6f;
constexpr int NPHASE = 8;

constexpr size_t WS_CNT = 0, WS_MOD = 4096, WS_WOUT = 131072;
constexpr size_t WS_GATES = WS_WOUT + (size_t)DM * DM * 2;
constexpr size_t WS_Z = WS_GATES + (size_t)MROWS * 32 * 2;
constexpr size_t WS_QKVA = WS_Z + (size_t)MROWS * 2048 * 2;
constexpr size_t WS_QKVG = WS_QKVA + (size_t)MROWS * 1536 * 2;
constexpr size_t WS_FRAG = WS_QKVG + (size_t)MROWS * 3072 * 2;
constexpr size_t DIR_BYTES = 16384 + 8192 + 1024 + 16384;
constexpr size_t ITEM_BYTES = 32768 + 2 * DIR_BYTES;
constexpr size_t WS_WIN = WS_FRAG;
constexpr size_t WS_H = WS_FRAG + (size_t)NPAD * DM * 2;
constexpr size_t WS_END = WS_FRAG + (size_t)NB * GH * NCH * ITEM_BYTES;
static_assert(WS_H + (size_t)MROWS * DM * 2 <= WS_END, "H inside FRAG region");
static_assert((size_t)2 * NB * SEQ * 1024 * 2 <= (size_t)MROWS * 3072 * 2, "O_gdn fits over QKVG");

constexpr int LDS_BYTES = 147456;

typedef unsigned short bfu;
typedef float f32x16 __attribute__((ext_vector_type(16)));
typedef unsigned u32x2 __attribute__((ext_vector_type(2)));
__device__ __forceinline__ float bf2f(unsigned short u) { return __uint_as_float(((unsigned)u) << 16); }
__device__ __forceinline__ float bflo(unsigned w) { return __uint_as_float(w << 16); }
__device__ __forceinline__ float bfhi(unsigned w) { return __uint_as_float(w & 0xffff0000u); }
__device__ __forceinline__ float wave_sum(float v) {
#pragma unroll
    for (int o = 1; o < 64; o <<= 1) v += __shfl_xor(v, o);
    return v;
}
__device__ __forceinline__ float siluf(float x) { return x / (1.f + __expf(-x)); }

namespace pg8 {
#define PG8_LAS __attribute__((address_space(3)))
typedef unsigned short bf16_t;
typedef short bf16x8 __attribute__((ext_vector_type(8)));
typedef float f32x4 __attribute__((ext_vector_type(4)));
typedef unsigned u32x4 __attribute__((ext_vector_type(4)));
constexpr int BM = 256, BK = 64, HALF = 128, HTB = HALF * BK * 2  , STAGE_BYTES = 8 * HTB, NXCD = 8, WGM = 8;

__host__ __device__ __forceinline__ int lds_byte(int r, int c) { const int st = (r >> 4) * 2 + (c >> 5), rr = r & 15, cc = c & 31, ob = rr * 64 + cc * 2; return st * 1024 + (ob ^ (((ob >> 9) & 1) << 5)); }
__host__ __device__ __forceinline__ void stage_rc(int b, int& R, int& C) { const int st = b / 1024, sb = b % 1024, swz = sb ^ (((sb >> 9) & 1) << 5); R = (st >> 1) * 16 + swz / 64; C = (st & 1) * 32 + (swz % 64) / 2; }
__host__ __device__ __forceinline__ int perm32(int rho) { const int n = rho >> 4, i = rho & 15; return 8 * (i >> 2) + 4 * n + (i & 3); }

struct Unit { int pm, pn; };
struct Gemm { const bf16_t* A; const bf16_t* Bt; int M, N, K; };

struct StaticOrder {
    int nM, nN, nwg, G, c;
    __host__ __device__ void init(int M, int N, int G_, int c_) { nM = M / BM; nN = N / BM; nwg = nM * nN; G = G_; c = c_; }
    __host__ __device__ bool next(int i, Unit& u) const {
        const long L = (long)i * G + c; if (L >= nwg) return false;
        int wgid = (int)L; { const int q = nwg / NXCD, r = nwg % NXCD, xcd = wgid % NXCD, off = wgid / NXCD; wgid = (xcd < r ? xcd * (q + 1) : r * (q + 1) + (xcd - r) * q) + off; }
        const int nig = WGM * nN, gid = wgid / nig, fm = gid * WGM, gsz = (nM - fm) < WGM ? (nM - fm) : WGM;
        u.pm = fm + ((wgid % nig) % gsz); u.pn = (wgid % nig) / gsz; return true;
    }
    __device__ __forceinline__ void a_ready(const Unit&) const {}
    __device__ __forceinline__ void done(const Unit&) const {}
};

__device__ __forceinline__ unsigned cvt_pk_bf16(float lo, float hi) { unsigned r; asm volatile("v_cvt_pk_bf16_f32 %0, %1, %2" : "=v"(r) : "v"(lo), "v"(hi)); return r; }
template <class Epi, class Sched, bool ALIGN_EPI = false, bool SP2 = false>
__device__ __forceinline__ void gemm_phase(PG8_LAS unsigned char* lds, const Gemm g, const Sched& S, const Epi& E) {
    const int tid = threadIdx.x, wid = __builtin_amdgcn_readfirstlane(tid >> 6), lane = tid & 63, wr = wid >> 2, wc = wid & 3, fr = lane & 15, fq = lane >> 4;
    const int K = g.K, nt = K / BK;
    unsigned voffA[2], voffB[2];
#pragma unroll
    for (int i = 0; i < 2; ++i) { int R, C; stage_rc(tid * 16 + i * 8192, R, C); const int Rb = Epi::PERM ? ((R & ~31) + perm32(R & 31)) : R;
        voffA[i] = (unsigned)(R * K + C) * 2u; voffB[i] = (unsigned)(Rb * K + C) * 2u; }
    const size_t kstep = (size_t)(BK * 2);
    const size_t hstep = (size_t)HALF * K * 2;
    const size_t tstep = 2 * hstep;
    const unsigned ldsw = (unsigned)wid * 1024u;
    const int aoff = lds_byte(wr * 64 + fr, fq * 8), boff = lds_byte(wc * 32 + fr, fq * 8);
#define PG8_SA(b, h) (((b) * 2 + (h)) * HTB)
#define PG8_SB(b, h) ((4 + (b) * 2 + (h)) * HTB)
#define PG8_STAGE(bufoff, gbase, voff) do { _Pragma("unroll") for (int _i = 0; _i < 2; ++_i) \
        __builtin_amdgcn_global_load_lds((const unsigned*)((const char*)(gbase) + (voff)[_i]), (PG8_LAS unsigned*)(lds + (bufoff) + ldsw + _i * 8192), 16, 0, 0); } while (0)
#define PG8_LDA(dst, b, h) do { _Pragma("unroll") for (int m = 0; m < 4; ++m) _Pragma("unroll") for (int k = 0; k < 2; ++k) dst[m][k] = *(const PG8_LAS bf16x8*)(lds + PG8_SA(b, h) + aoff + m * 2048 + k * 1024); } while (0)
#define PG8_LDB(dst, b, h) do { _Pragma("unroll") for (int n = 0; n < 2; ++n) _Pragma("unroll") for (int k = 0; k < 2; ++k) dst[n][k] = *(const PG8_LAS bf16x8*)(lds + PG8_SB(b, h) + boff + n * 2048 + k * 1024); } while (0)
#define PG8_MMA(ai, bj, At, Bt) do { __builtin_amdgcn_s_setprio(1); _Pragma("unroll") for (int m = 0; m < 4; ++m) _Pragma("unroll") for (int n = 0; n < 2; ++n) _Pragma("unroll") for (int k = 0; k < 2; ++k) \
        acc[ai][bj][m][n] = __builtin_amdgcn_mfma_f32_16x16x32_bf16(Bt[n][k], At[m][k], acc[ai][bj][m][n], 0, 0, 0); __builtin_amdgcn_s_setprio(0); } while (0)
#define PG8_WAIT_V(n) asm volatile("s_waitcnt vmcnt(" #n ")" ::: "memory")
#define PG8_WAIT_L(n) asm volatile("s_waitcnt lgkmcnt(" #n ")" ::: "memory")
#define PG8_BAR __builtin_amdgcn_s_barrier()
#define PG8_SCHED __builtin_amdgcn_sched_barrier(0)
    Unit cur, nxt; int ui = 0;
    if (!S.next(0, cur)) return;
    f32x4 acc[2][2][4][2];
#pragma unroll
    for (int a = 0; a < 2; ++a)
#pragma unroll
        for (int b = 0; b < 2; ++b)
#pragma unroll
            for (int m = 0; m < 4; ++m)
#pragma unroll
                for (int n = 0; n < 2; ++n) acc[a][b][m][n] = (f32x4){0.f, 0.f, 0.f, 0.f};
    bf16x8 At[4][2], B0[2][2], B1[2][2];
    const char* cA = (const char*)g.A + (size_t)cur.pm * tstep; const char* cB = (const char*)g.Bt + (size_t)cur.pn * tstep;
    S.a_ready(cur);
    if constexpr (SP2) {
        PG8_STAGE(PG8_SB(0, 0), cB, voffB); PG8_STAGE(PG8_SB(0, 1), cB + hstep, voffB); PG8_STAGE(PG8_SA(0, 0), cA, voffA); PG8_STAGE(PG8_SA(0, 1), cA + hstep, voffA);
        if (wr == 1) PG8_BAR;
        PG8_WAIT_V(2); PG8_BAR;
        PG8_STAGE(PG8_SB(1, 0), cB + kstep, voffB); PG8_STAGE(PG8_SA(1, 0), cA + kstep, voffA); PG8_STAGE(PG8_SB(1, 1), cB + hstep + kstep, voffB);
        PG8_WAIT_V(6); PG8_BAR;
    } else {
        PG8_STAGE(PG8_SB(0, 0), cB, voffB); PG8_STAGE(PG8_SA(0, 0), cA, voffA); PG8_STAGE(PG8_SB(0, 1), cB + hstep, voffB); PG8_STAGE(PG8_SA(0, 1), cA + hstep, voffA);
        if (wr == 1) PG8_BAR;
        PG8_WAIT_V(4); PG8_BAR;
        PG8_STAGE(PG8_SB(1, 0), cB + kstep, voffB); PG8_STAGE(PG8_SA(1, 0), cA + kstep, voffA); PG8_STAGE(PG8_SB(1, 1), cB + hstep + kstep, voffB);
        PG8_WAIT_V(6); PG8_BAR;
    }
    for (;;) {
        const bool has_next = S.next(ui + 1, nxt);
        const char* nA = has_next ? (const char*)g.A + (size_t)nxt.pm * tstep : cA; const char* nB = has_next ? (const char*)g.Bt + (size_t)nxt.pn * tstep : cB;
        for (int t = 0; t < nt; t += 2) {
            const bool last = (t == nt - 2);
            const char* a1 = cA + (size_t)(t + 1) * kstep;
            const char* a2 = last ? nA : cA + (size_t)(t + 2) * kstep; const char* b2 = last ? nB : cB + (size_t)(t + 2) * kstep;
            const char* a3 = a2 + kstep; const char* b3 = b2 + kstep;
            if (last && has_next) S.a_ready(nxt);
            if constexpr (SP2) {
            PG8_LDB(B0, 0, 0); PG8_LDB(B1, 0, 1); PG8_SCHED; PG8_LDA(At, 0, 0); PG8_STAGE(PG8_SA(1, 1), a1 + hstep, voffA);
            PG8_WAIT_V(8); PG8_WAIT_L(0); PG8_BAR; PG8_MMA(0, 0, At, B0); PG8_MMA(0, 1, At, B1); PG8_BAR; PG8_SCHED;
            PG8_LDA(At, 0, 1); PG8_STAGE(PG8_SB(0, 0), b2, voffB); PG8_STAGE(PG8_SB(0, 1), b2 + hstep, voffB); PG8_STAGE(PG8_SA(0, 0), a2, voffA);
            PG8_WAIT_V(8); PG8_WAIT_L(0); PG8_BAR; PG8_MMA(1, 0, At, B0); PG8_MMA(1, 1, At, B1); PG8_BAR; PG8_SCHED;
            PG8_LDB(B0, 1, 0); PG8_LDB(B1, 1, 1); PG8_SCHED; PG8_LDA(At, 1, 0); PG8_STAGE(PG8_SA(0, 1), a2 + hstep, voffA);
            PG8_WAIT_V(8); PG8_WAIT_L(0); PG8_BAR; PG8_MMA(0, 0, At, B0); PG8_MMA(0, 1, At, B1); PG8_BAR; PG8_SCHED;
            PG8_LDA(At, 1, 1); PG8_STAGE(PG8_SB(1, 0), b3, voffB); PG8_STAGE(PG8_SB(1, 1), b3 + hstep, voffB); PG8_STAGE(PG8_SA(1, 0), a3, voffA);
            PG8_WAIT_V(8); PG8_WAIT_L(0); PG8_BAR; PG8_MMA(1, 0, At, B0); PG8_MMA(1, 1, At, B1); PG8_BAR; PG8_SCHED;
            } else {
            PG8_LDB(B0, 0, 0); PG8_SCHED; PG8_LDA(At, 0, 0); PG8_STAGE(PG8_SA(1, 1), a1 + hstep, voffA);
            PG8_WAIT_L(8); PG8_BAR; PG8_WAIT_L(0); PG8_MMA(0, 0, At, B0); PG8_BAR; PG8_SCHED;
            PG8_LDB(B1, 0, 1); PG8_STAGE(PG8_SB(0, 0), b2, voffB);
            PG8_BAR; PG8_WAIT_L(0); PG8_MMA(0, 1, At, B1); PG8_BAR;
            PG8_LDA(At, 0, 1); PG8_STAGE(PG8_SA(0, 0), a2, voffA);
            PG8_BAR; PG8_WAIT_L(0); PG8_MMA(1, 0, At, B0); PG8_BAR; PG8_SCHED;
            PG8_STAGE(PG8_SB(0, 1), b2 + hstep, voffB);
            PG8_WAIT_V(6); PG8_BAR; PG8_MMA(1, 1, At, B1); PG8_BAR;
            PG8_LDB(B0, 1, 0); PG8_SCHED; PG8_LDA(At, 1, 0); PG8_STAGE(PG8_SA(0, 1), a2 + hstep, voffA);
            PG8_WAIT_L(8); PG8_BAR; PG8_WAIT_L(0); PG8_MMA(0, 0, At, B0); PG8_BAR; PG8_SCHED;
            PG8_LDB(B1, 1, 1); PG8_STAGE(PG8_SB(1, 0), b3, voffB);
            PG8_BAR; PG8_WAIT_L(0); PG8_MMA(0, 1, At, B1); PG8_BAR;
            PG8_LDA(At, 1, 1); PG8_STAGE(PG8_SA(1, 0), a3, voffA);
            PG8_BAR; PG8_WAIT_L(0); PG8_MMA(1, 0, At, B0); PG8_BAR; PG8_SCHED;
            PG8_STAGE(PG8_SB(1, 1), b3 + hstep, voffB);
            PG8_WAIT_V(6); PG8_BAR; PG8_MMA(1, 1, At, B1); PG8_BAR;
            }
        }
        if constexpr (ALIGN_EPI) { if (wr == 0) PG8_BAR; }
        if constexpr (!Epi::AFTER_DRAIN) { E(acc, cur, wr, wc, fr, fq); S.done(cur); }
        if (!has_next) break;
#pragma unroll
        for (int a = 0; a < 2; ++a)
#pragma unroll
            for (int b = 0; b < 2; ++b)
#pragma unroll
                for (int m = 0; m < 4; ++m)
#pragma unroll
                    for (int n = 0; n < 2; ++n) acc[a][b][m][n] = (f32x4){0.f, 0.f, 0.f, 0.f};
        cur = nxt; cA = nA; cB = nB; ++ui;
        if constexpr (ALIGN_EPI) { if (wr == 1) PG8_BAR; }
    }
    PG8_WAIT_V(0);
    if constexpr (!ALIGN_EPI) { if (wr == 0) PG8_BAR; }
    PG8_BAR;
    if constexpr (Epi::AFTER_DRAIN) { E.fused(acc, cur, wr, wc, fr, fq, lds, wid, lane); S.done(cur); }
#undef PG8_SA
#undef PG8_SB
#undef PG8_STAGE
#undef PG8_LDA
#undef PG8_LDB
#undef PG8_MMA
#undef PG8_WAIT_V
#undef PG8_WAIT_L
#undef PG8_BAR
#undef PG8_SCHED
}
}

namespace att {
using bf16 = __hip_bfloat16;
constexpr int D = 128, NW = 8, QBLK = 32, KVBLK = 64;
constexpr float SCALE = 0.088388347648318440f;
constexpr float THR = 8.f;
constexpr int SDEPTH = 2;
constexpr int LDQ = 1536, LDK = 1536, LDO = 2048;
constexpr size_t SHM_V = KVBLK * D * 2, SHM_K = KVBLK * D * 2, SHM_ATTN = 2 * SHM_V + 2 * SHM_K + NW * 64 * 4;
using bf16x8 = __attribute__((ext_vector_type(8))) short;
using s16x4  = __attribute__((ext_vector_type(4))) short;
using f32x16 = __attribute__((ext_vector_type(16))) float;
using f32x8  = __attribute__((ext_vector_type(8))) float;
using u32x4  = __attribute__((ext_vector_type(4))) unsigned;
#define KSWZ(row, colB) ((row) * 256 + ((colB) ^ (((row) & 7) << 4)))
#define SBAR() __builtin_amdgcn_sched_barrier(0)
__device__ __forceinline__ int crow(int r, int hi) { return (r & 3) + 8 * (r >> 2) + 4 * hi; }
__device__ __forceinline__ unsigned cvtpk(float lo, float hi) {
  unsigned r; asm volatile("v_cvt_pk_bf16_f32 %0, %1, %2" : "=v"(r) : "v"(lo), "v"(hi)); return r;
}
template <typename TIn> struct Stage;
template <> struct Stage<bf16>  { using T = bf16x8;
  __device__ static __forceinline__ T ld8(const bf16* p) { return *reinterpret_cast<const bf16x8*>(p); }
  __device__ static __forceinline__ bf16x8 tobf(T x) { return x; } };
template <> struct Stage<float> { using T = f32x8;
  __device__ static __forceinline__ T ld8(const float* p) { return *reinterpret_cast<const f32x8*>(p); }
  __device__ static __forceinline__ bf16x8 tobf(T x) {
    u32x4 w = {cvtpk(x[0], x[1]), cvtpk(x[2], x[3]), cvtpk(x[4], x[5]), cvtpk(x[6], x[7])}; return *reinterpret_cast<bf16x8*>(&w); } };

__device__ __forceinline__ void partialSM(f32x16& p0, f32x16& p1, float& m_reg, float& mn, float& alpha) {
  constexpr float C = SCALE * 1.4426950408889634f;
  float pmax = p0[0]; for (int r = 1; r < 16; ++r) pmax = fmaxf(pmax, p0[r]); for (int r = 0; r < 16; ++r) pmax = fmaxf(pmax, p1[r]);
  { auto rr = __builtin_amdgcn_permlane32_swap(__float_as_uint(pmax), __float_as_uint(pmax), false, false);
    pmax = fmaxf(__uint_as_float(rr[0]), __uint_as_float(rr[1])); }
  if (__builtin_expect(__all(pmax - m_reg <= THR / SCALE), 1)) { mn = m_reg; alpha = 1.f; }
  else { mn = fmaxf(m_reg, pmax); alpha = __builtin_amdgcn_exp2f((m_reg - mn) * C); m_reg = mn; }
  float mnC = -mn * C;
  for (int r = 0; r < 16; ++r) p0[r] = fmaf(p0[r], C, mnC); for (int r = 0; r < 16; ++r) p1[r] = fmaf(p1[r], C, mnC);
  for (int r = 0; r < 16; ++r) p0[r] = __builtin_amdgcn_exp2f(p0[r]);
}
__device__ __forceinline__ void finishSM(f32x16& p0, f32x16& p1, float alpha, float& l_reg, bf16x8& pa0, bf16x8& pa1, bf16x8& pa2, bf16x8& pa3) {
  for (int r = 0; r < 16; ++r) p1[r] = __builtin_amdgcn_exp2f(p1[r]);
  float ps = 0; for (int r = 0; r < 16; ++r) ps += p0[r]; for (int r = 0; r < 16; ++r) ps += p1[r];
  { auto rr = __builtin_amdgcn_permlane32_swap(__float_as_uint(ps), __float_as_uint(ps), false, false);
    ps = __uint_as_float(rr[0]) + __uint_as_float(rr[1]); }
  l_reg = l_reg * alpha + ps;
#define PK4(P, BASE, OUT) do { unsigned a0 = cvtpk(P[BASE + 0], P[BASE + 1]), a1 = cvtpk(P[BASE + 2], P[BASE + 3]);   \
    unsigned b0 = cvtpk(P[BASE + 4], P[BASE + 5]), b1 = cvtpk(P[BASE + 6], P[BASE + 7]);                              \
    auto r0 = __builtin_amdgcn_permlane32_swap(a0, b0, false, false); auto r1 = __builtin_amdgcn_permlane32_swap(a1, b1, false, false); \
    u32x4 w = {r0[0], r1[0], r0[1], r1[1]}; OUT = *reinterpret_cast<bf16x8*>(&w); } while (0)
  PK4(p0, 0, pa0); PK4(p0, 8, pa1); PK4(p1, 0, pa2); PK4(p1, 8, pa3);
#undef PK4
}
__device__ __forceinline__ void qkt(f32x16& p0, f32x16& p1, const bf16* Ks, const bf16x8* qr, int r32, int hi) {
  p0 = f32x16{}; p1 = f32x16{};
  for (int d0 = 0; d0 < 8; ++d0) { int cb = (d0 * 16 + hi * 8) * 2;
    bf16x8 b0 = *reinterpret_cast<const bf16x8*>((const char*)Ks + KSWZ(r32, cb));
    bf16x8 b1 = *reinterpret_cast<const bf16x8*>((const char*)Ks + KSWZ(32 + r32, cb));
    p0 = __builtin_amdgcn_mfma_f32_32x32x16_bf16(b0, qr[d0], p0, 0, 0, 0);
    p1 = __builtin_amdgcn_mfma_f32_32x32x16_bf16(b1, qr[d0], p1, 0, 0, 0); }
}
__device__ __forceinline__ int v_st(int k, int c) { const int kk = (k & ~0xC) | ((k & 4) << 1) | ((k & 8) >> 1); return ((kk >> 3) * 4 + (c >> 5)) * 512 + ((kk & 7) * 32 + (c & 31)) * 2; }
__device__ __forceinline__ int v_rd_base(int lane) { return ((lane & 3) << 3) | (((lane >> 2) & 3) << 6) | (((lane >> 4) & 1) << 5) | (((lane >> 5) & 1) << 8); }
constexpr int v_rd_off(int d0, int ks, int half) { return d0 * 512 + ks * 4096 + half * 2048; }
template <int OFF> __device__ __forceinline__ s16x4 tr_read(int vb) {
  s16x4 r; asm volatile("ds_read_b64_tr_b16 %0, %1 offset:%2" : "=&v"(r) : "v"(vb), "i"(OFF) : "memory"); return r;
}
template <int D0> __device__ __forceinline__ void pv_one(f32x16& od, int vb, bf16x8 pa0, bf16x8 pa1, bf16x8 pa2, bf16x8 pa3) {
  const s16x4 l0 = tr_read<v_rd_off(D0, 0, 0)>(vb), h0 = tr_read<v_rd_off(D0, 0, 1)>(vb), l1 = tr_read<v_rd_off(D0, 1, 0)>(vb), h1 = tr_read<v_rd_off(D0, 1, 1)>(vb);
  const s16x4 l2 = tr_read<v_rd_off(D0, 2, 0)>(vb), h2 = tr_read<v_rd_off(D0, 2, 1)>(vb), l3 = tr_read<v_rd_off(D0, 3, 0)>(vb), h3 = tr_read<v_rd_off(D0, 3, 1)>(vb);
  asm volatile("s_waitcnt lgkmcnt(0)" ::: "memory"); SBAR();
#define PK(L, H) (bf16x8){L[0], L[1], L[2], L[3], H[0], H[1], H[2], H[3]}
  od = __builtin_amdgcn_mfma_f32_32x32x16_bf16(pa0, PK(l0, h0), od, 0, 0, 0);
  od = __builtin_amdgcn_mfma_f32_32x32x16_bf16(pa1, PK(l1, h1), od, 0, 0, 0);
  od = __builtin_amdgcn_mfma_f32_32x32x16_bf16(pa2, PK(l2, h2), od, 0, 0, 0);
  od = __builtin_amdgcn_mfma_f32_32x32x16_bf16(pa3, PK(l3, h3), od, 0, 0, 0);
#undef PK
}
__device__ __forceinline__ void pv_d0(f32x16* o, int vb, bf16x8 pa0, bf16x8 pa1, bf16x8 pa2, bf16x8 pa3) {
  pv_one<0>(o[0], vb, pa0, pa1, pa2, pa3); pv_one<1>(o[1], vb, pa0, pa1, pa2, pa3); pv_one<2>(o[2], vb, pa0, pa1, pa2, pa3); pv_one<3>(o[3], vb, pa0, pa1, pa2, pa3);
}

template <typename TQ>
__device__ __forceinline__ void attn_dense_body(const TQ* __restrict__ Qb, const bf16* __restrict__ Kh, const bf16* __restrict__ Vh,
                                                unsigned short* Ob, int seq, char* lds) {
  using St = Stage<bf16>; using SQ = Stage<TQ>;
  int tid_o = threadIdx.x; asm volatile("" : "+v"(tid_o));
  const int tid = tid_o, wid = tid >> 6, lane = tid & 63, r32 = lane & 31, hi = lane >> 5;
  bf16* V_lds = (bf16*)lds; bf16* K_lds = (bf16*)(lds + 2 * SHM_V);
  float* ws = (float*)(lds + 2 * SHM_V + 2 * SHM_K) + wid * 64; float* li_l = ws; float* al_l = ws + 32;
  float m_reg = -1e30f, l_reg = 0; f32x16 o[4] = {}; bf16x8 qr[8];
  const TQ* Qw = Qb + (long)(wid * QBLK + r32) * LDQ + hi * 8;
#pragma unroll
  for (int d0 = 0; d0 < 8; ++d0) qr[d0] = SQ::tobf(SQ::ld8(Qw + d0 * 16));
  const int sr = tid >> 4, sc = (tid & 15) * 8, vst0 = v_st(sr, sc), vst1 = v_st(32 + sr, sc);
  const int vb0 = (int)(uintptr_t)V_lds + v_rd_base(lane);
  struct { typename St::T vs0, vs1, ks0, ks1; } sr_[SDEPTH];
#define SLOAD(i, k0) do { sr_[i].vs0 = St::ld8(&Vh[(long)((k0) + sr) * LDK + sc]); sr_[i].vs1 = St::ld8(&Vh[(long)((k0) + 32 + sr) * LDK + sc]); \
    sr_[i].ks0 = St::ld8(&Kh[(long)((k0) + sr) * LDK + sc]); sr_[i].ks1 = St::ld8(&Kh[(long)((k0) + 32 + sr) * LDK + sc]); } while (0)
#define SWRITE(b, i) do { *(bf16x8*)((char*)V_lds + (b) * SHM_V + vst0) = St::tobf(sr_[i].vs0);          \
    *(bf16x8*)((char*)V_lds + (b) * SHM_V + vst1) = St::tobf(sr_[i].vs1); int kc = sc * 2;               \
    *(bf16x8*)((char*)K_lds + (b) * SHM_K + KSWZ(sr, kc)) = St::tobf(sr_[i].ks0);                       \
    *(bf16x8*)((char*)K_lds + (b) * SHM_K + KSWZ(32 + sr, kc)) = St::tobf(sr_[i].ks1); } while (0)
#define SWAIT() do { if constexpr (SDEPTH == 2) asm volatile("s_waitcnt vmcnt(4)" ::: "memory"); else asm volatile("s_waitcnt vmcnt(0)" ::: "memory"); } while (0)
#define RESC(a) do { if (__any((a) < 1.f)) { if (hi == 0) al_l[r32] = (a); asm volatile("s_waitcnt lgkmcnt(0)" ::: "memory"); \
    for (int d = 0; d < 4; ++d) for (int r = 0; r < 16; ++r) o[d][r] *= al_l[crow(r, hi)]; } } while (0)
  f32x16 pA0, pA1, pB0, pB1; float mnA, mnB, alA, alB; bf16x8 pa0, pa1, pa2, pa3; const int NT = seq / KVBLK;
  constexpr int SE = 0, SO = SDEPTH - 1;
  SLOAD(SE, 0); asm volatile("s_waitcnt vmcnt(0)" ::: "memory"); SWRITE(0, SE); __syncthreads();
  qkt(pA0, pA1, K_lds, qr, r32, hi); partialSM(pA0, pA1, m_reg, mnA, alA);
  SLOAD(SO, KVBLK); if constexpr (SDEPTH == 2) { if (2 < NT) SLOAD(SE, 2 * KVBLK); }
  SWAIT(); SWRITE(1, SO); __syncthreads();
  for (int j = 1; j + 1 < NT; j += 2) {
    SBAR(); qkt(pB0, pB1, (bf16*)((char*)K_lds + SHM_K), qr, r32, hi);
    finishSM(pA0, pA1, alA, l_reg, pa0, pa1, pa2, pa3); SBAR();
    SLOAD(SO, (j + SDEPTH) * KVBLK); SBAR();
    pv_d0(o, vb0, pa0, pa1, pa2, pa3); partialSM(pB0, pB1, m_reg, mnB, alB);
    __syncthreads(); SWAIT(); SWRITE(0, SE);
    RESC(alB); __syncthreads();
    SBAR(); qkt(pA0, pA1, K_lds, qr, r32, hi);
    finishSM(pB0, pB1, alB, l_reg, pa0, pa1, pa2, pa3); SBAR();
    if (SDEPTH == 1 || j + 3 < NT) SLOAD(SE, (j + 1 + SDEPTH) * KVBLK); SBAR();
    pv_d0(o, vb0 + (int)SHM_V, pa0, pa1, pa2, pa3); partialSM(pA0, pA1, m_reg, mnA, alA);
    __syncthreads(); SWAIT(); SWRITE(1, SO);
    RESC(alA); __syncthreads();
  }
  SBAR(); qkt(pB0, pB1, (bf16*)((char*)K_lds + SHM_K), qr, r32, hi);
  finishSM(pA0, pA1, alA, l_reg, pa0, pa1, pa2, pa3); SBAR();
  pv_d0(o, vb0, pa0, pa1, pa2, pa3); partialSM(pB0, pB1, m_reg, mnB, alB);
  __syncthreads(); RESC(alB);
  finishSM(pB0, pB1, alB, l_reg, pa0, pa1, pa2, pa3); SBAR();
  pv_d0(o, vb0 + (int)SHM_V, pa0, pa1, pa2, pa3);
  if (hi == 0) li_l[r32] = l_reg; asm volatile("s_waitcnt lgkmcnt(0)" ::: "memory");
  float rli[16];
#pragma unroll
  for (int r = 0; r < 16; ++r) rli[r] = __builtin_amdgcn_rcpf(li_l[crow(r, hi)]);
  unsigned short* Ow = Ob + (long)(wid * QBLK) * LDO;
#pragma unroll
  for (int r = 0; r < 16; ++r) { int orow = crow(r, hi);
#pragma unroll
    for (int d0 = 0; d0 < 4; ++d0) { unsigned short* p = Ow + (long)orow * LDO + d0 * 32 + r32; const float z = __uint_as_float(((unsigned)*p) << 16);
      const float v = o[d0][r] * rli[r] * z / (1.f + __expf(-z)); *p = (unsigned short)(cvtpk(v, 0.f) & 0xffffu); } }
#undef SLOAD
#undef SWRITE
#undef SWAIT
#undef RESC
}

}

typedef short v8s __attribute__((ext_vector_type(8)));
typedef float v4f __attribute__((ext_vector_type(4)));
typedef unsigned v4u __attribute__((ext_vector_type(4)));
#define MFMA32(a, b, c) __builtin_amdgcn_mfma_f32_32x32x16_bf16((a), (b), (c), 0, 0, 0)
typedef float f32x2_t __attribute__((ext_vector_type(2))); typedef __bf16 bf16x2_t __attribute__((ext_vector_type(2)));
__device__ __forceinline__ unsigned cvtpk2(float lo, float hi) { f32x2_t v = {lo, hi}; bf16x2_t b = __builtin_convertvector(v, bf16x2_t); return __builtin_bit_cast(unsigned, b); }
__device__ __forceinline__ int crow_(int r, int hi) { return (r & 3) + 8 * (r >> 2) + 4 * hi; }
template <int BASE> __device__ __forceinline__ v8s pk4(const f32x16& P) {
    const unsigned a0 = cvtpk2(P[BASE + 0], P[BASE + 1]), a1 = cvtpk2(P[BASE + 2], P[BASE + 3]);
    const unsigned b0 = cvtpk2(P[BASE + 4], P[BASE + 5]), b1 = cvtpk2(P[BASE + 6], P[BASE + 7]);
    auto r0 = __builtin_amdgcn_permlane32_swap(a0, b0, false, false); auto r1 = __builtin_amdgcn_permlane32_swap(a1, b1, false, false);
    v4u w = {r0[0], r1[0], r0[1], r1[1]}; return __builtin_bit_cast(v8s, w);
}

struct Args { const float* in[16]; float* out; unsigned char* ws; int ph_lo, ph_hi; };

__device__ __forceinline__ void transpose_item(const float* __restrict__ W, int N, bfu* __restrict__ WT, int K, int k0, int n0, int dn0, float* scr, int lane) {
#pragma unroll 8
    for (int i = 0; i < 32; ++i) { const int kk = 2 * i + (lane >> 5); scr[kk * 33 + (lane & 31)] = W[(size_t)(k0 + kk) * N + n0 + (lane & 31)]; }
    asm volatile("s_waitcnt lgkmcnt(0)" ::: "memory");
    const int c = lane & 7;
#pragma unroll
    for (int j = 0; j < 4; ++j) { const int n = (lane >> 3) + 8 * j; const float* s = scr + (8 * c) * 33 + n;
        v4u o; o.x = cvtpk2(s[0 * 33], s[1 * 33]); o.y = cvtpk2(s[2 * 33], s[3 * 33]); o.z = cvtpk2(s[4 * 33], s[5 * 33]); o.w = cvtpk2(s[6 * 33], s[7 * 33]);
        *(v4u*)(WT + (size_t)(dn0 + n) * K + k0 + 8 * c) = o; }
    asm volatile("s_waitcnt lgkmcnt(0)" ::: "memory");
}
__device__ __forceinline__ void phase0(const Args& a, char* lds) {
    const int tid = threadIdx.x, lane = tid & 63, wave = tid >> 6;
    unsigned char* ws = a.ws;
    if (blockIdx.x == 0 && tid == 0) { ((unsigned*)(ws + WS_CNT))[0] = 0u; }
    float* sv = (float*)lds; float* red = (float*)(lds + 24576);
    const float* c = a.in[1]; const float* cc = a.in[3]; const float* w_ada = a.in[4]; const float* b_ada = a.in[5];
    float* MOD = (float*)(ws + WS_MOD);
    if (blockIdx.x < 192) {
        for (int i = tid; i < 3 * 2048; i += 512) { const float v = i < 4096 ? c[i] : cc[i - 4096]; sv[i] = siluf(v); }
        __syncthreads();
        for (int cgp = blockIdx.x; cgp < 192; cgp += gridDim.x) {
            const int sub = tid & 7, rg = tid >> 3;
            v4f acc0 = {0.f, 0.f, 0.f, 0.f}, acc1 = acc0, acc2 = acc0;
            const float* wp = w_ada + (size_t)(rg * 32) * 6144 + cgp * 32 + sub * 4;
#pragma unroll 8
            for (int rr = 0; rr < 32; ++rr) { const v4f w = *(const v4f*)(wp + (size_t)rr * 6144); const int k = rg * 32 + rr; acc0 += sv[k] * w; acc1 += sv[2048 + k] * w; acc2 += sv[4096 + k] * w; }
            float* rp = red + rg * 96 + sub * 4;
            *(v4f*)(rp) = acc0; *(v4f*)(rp + 32) = acc1; *(v4f*)(rp + 64) = acc2;
            __syncthreads();
            if (tid < 96) { float s = 0.f; for (int g = 0; g < 64; ++g) s += red[g * 96 + tid]; const int v = tid >> 5, cix = tid & 31; MOD[v * 6144 + cgp * 32 + cix] = s + b_ada[cgp * 32 + cix]; }
            __syncthreads();
        }
    }
    __syncthreads();
    float* scr = (float*)(lds + wave * 8448);
    const int gw = blockIdx.x * 8 + wave, NGW = gridDim.x * 8;
    const float* w_in = a.in[7]; const float* w_out = a.in[14];
    bfu* WinT = (bfu*)(ws + WS_WIN); bfu* WoutT = (bfu*)(ws + WS_WOUT);
    constexpr int I_IN = 32 * 209, I_OUT = 32 * 64;
    for (int it = gw; it < I_IN + I_OUT; it += NGW) {
        if (it < I_IN) { const int kb = it / 209, nb = it % 209, n0 = nb * 32;
            const int dn0 = n0 < 4096 ? n0 : (n0 < 4128 ? n0 + 2560 : (n0 < 5664 ? n0 + 992 : n0 - 1568));
            transpose_item(w_in, INC, WinT, DM, kb * 64, n0, dn0, scr, lane);
        } else { const int r = it - I_IN, kb = r / 64, nb = r % 64; transpose_item(w_out, DM, WoutT, DM, kb * 64, nb * 32, nb * 32, scr, lane); }
    }
    { v4u z = {0u, 0u, 0u, 0u}; v4u* pz = (v4u*)(WinT + (size_t)INC * DM); const int n16 = (NPAD - INC) * DM * 2 / 16;
      for (int i = blockIdx.x * 512 + tid; i < n16; i += gridDim.x * 512) pz[i] = z; }
}

__device__ __forceinline__ void phase1(const Args& a) {
    const int tid = threadIdx.x, lane = tid & 63, wave = tid >> 6;
    const int gw = blockIdx.x * 8 + wave, NGW = gridDim.x * 8;
    const float* x = a.in[0]; const float* ctx = a.in[2]; const float* nw = a.in[6];
    const float* MOD = (const float*)(a.ws + WS_MOD); bfu* H = (bfu*)(a.ws + WS_H);
    for (int row = gw; row < MROWS; row += NGW) {
        const int b = row / TOK, tl = row - b * TOK;
        const float* src = tl < CTXL ? ctx + ((size_t)b * CTXL + tl) * DM : x + ((size_t)b * SEQ + (tl - CTXL)) * DM;
        const float* shift = MOD + (tl < CTXL ? 2 : b) * 6144; const float* scale = shift + 2048;
        v4f v[8]; float ss = 0.f;
#pragma unroll
        for (int j = 0; j < 8; ++j) { v[j] = ((const v4f*)src)[lane + 64 * j]; ss += (v[j].x * v[j].x + v[j].y * v[j].y) + (v[j].z * v[j].z + v[j].w * v[j].w); }
        const float rstd = rsqrtf(wave_sum(ss) * (1.f / DM) + EPSF);
#pragma unroll
        for (int j = 0; j < 8; ++j) { const int col = (lane + 64 * j) * 4; const v4f w = *(const v4f*)(nw + col), sc = *(const v4f*)(scale + col), sh = *(const v4f*)(shift + col);
            const v4f y = (v[j] * rstd) * w * (1.f + sc) + sh; u32x2 o; o.x = cvtpk2(y.x, y.y); o.y = cvtpk2(y.z, y.w);
            *(u32x2*)(H + (size_t)row * DM + col) = o; }
    }
}

struct EpiIn {
    static constexpr bool PERM = true, AFTER_DRAIN = false;
    bfu* qkvg; bfu* z; bfu* qkva; bfu* gates;
    __device__ __forceinline__ void operator()(const pg8::f32x4 (&acc)[2][2][4][2], const pg8::Unit& u, int wr, int wc, int fr, int fq) const {
        bfu* base; int ld, colb; const int pn = u.pn;
        if (pn < 12) { base = qkvg; ld = 3072; colb = pn * 256; } else if (pn < 20) { base = z; ld = 2048; colb = (pn - 12) * 256; }
        else if (pn < 26) { base = qkva; ld = 1536; colb = (pn - 20) * 256; } else { base = gates; ld = 32; colb = 0; }
        const bool gt = pn >= 26;
        const int row0 = u.pm * 256 + wr * 64 + fr, col0 = colb + wc * 32 + 8 * fq;
#pragma unroll
        for (int ai = 0; ai < 2; ++ai)
#pragma unroll
            for (int m = 0; m < 4; ++m) { bfu* rowp = base + (size_t)(row0 + ai * 128 + m * 16) * ld + col0;
#pragma unroll
                for (int bj = 0; bj < 2; ++bj) { const pg8::f32x4 v0 = acc[ai][bj][m][0], v1 = acc[ai][bj][m][1];
                    v4u w; w.x = cvtpk2(v0[0], v0[1]); w.y = cvtpk2(v0[2], v0[3]); w.z = cvtpk2(v1[0], v1[1]); w.w = cvtpk2(v1[2], v1[3]);
                    if (!gt) *(v4u*)(rowp + bj * 128) = w; else if (bj == 0 && wc == 0) *(v4u*)(rowp) = w; } }
    }
};
struct EpiOut {
    static constexpr bool PERM = false, AFTER_DRAIN = false;
    const float* x; const float* mod; float* out;
    __device__ __forceinline__ void operator()(const pg8::f32x4 (&acc)[2][2][4][2], const pg8::Unit& u, int wr, int wc, int fr, int fq) const {
        const int b = u.pm >= 65 ? 1 : 0; const float* gate = mod + b * 6144 + 4096;
        const int col0 = u.pn * 256 + wc * 32 + 4 * fq;
#pragma unroll
        for (int ai = 0; ai < 2; ++ai)
#pragma unroll
            for (int m = 0; m < 4; ++m) { const int row = u.pm * 256 + ai * 128 + wr * 64 + m * 16 + fr; const size_t off = (size_t)(row - 256 * (b + 1)) * DM + col0;
#pragma unroll
                for (int bj = 0; bj < 2; ++bj)
#pragma unroll
                    for (int n = 0; n < 2; ++n) { const int cc = bj * 128 + n * 16; const v4f g = *(const v4f*)(gate + col0 + cc), xv = *(const v4f*)(x + off + cc);
                        const pg8::f32x4 av = acc[ai][bj][m][n]; v4f o; o.x = xv.x + g.x * av[0]; o.y = xv.y + g.y * av[1]; o.z = xv.z + g.z * av[2]; o.w = xv.w + g.w * av[3];
                        *(v4f*)(out + off + cc) = o; } }
    }
};
struct OutOrder { pg8::StaticOrder so;
    __device__ __forceinline__ bool next(int i, pg8::Unit& u) const { if (!so.next(i, u)) return false; u.pm = u.pm < 64 ? u.pm + 1 : u.pm + 2; return true; }
    __device__ __forceinline__ void a_ready(const pg8::Unit&) const {}
    __device__ __forceinline__ void done(const pg8::Unit&) const {}
};

__device__ __forceinline__ void phase3a(const Args& a) {
    const int tid = threadIdx.x, lane = tid & 63, wave = tid >> 6;
    const int gw = blockIdx.x * 8 + wave, NGW = gridDim.x * 8;
    bfu* QKVA = (bfu*)(a.ws + WS_QKVA); const float* qnw = a.in[12]; const float* knw = a.in[13];
    const int ax = lane >> 5, i = lane & 31, d1 = ax * 64 + i, d2 = d1 + 32;
    const float inv = exp2f(-(float)i * (13.287712379549449f / 32.f));
    const float qw1 = qnw[d1], qw2 = qnw[d2], kw1 = knw[d1], kw2 = knw[d2];
    for (int row = gw; row < MROWS; row += NGW) {
        const int b = row / TOK, tl = row - b * TOK; const bool isctx = tl < CTXL; const int t = tl - CTXL;
        float cs = 1.f, sn = 0.f;
        if (!isctx) { const float pos = (float)(ax == 0 ? (t >> 6) : (t & 63)); const float ang = pos * inv; float rev = ang * 0.15915494309189535f; rev -= floorf(rev);
            sn = __builtin_amdgcn_sinf(rev); cs = __builtin_amdgcn_cosf(rev); }
        bfu* base = QKVA + (size_t)row * 1536;
#pragma unroll
        for (int hh = 0; hh < 10; ++hh) { bfu* p = base + hh * 128;
            const float x1 = bf2f(p[d1]), x2 = bf2f(p[d2]);
            const float r = rsqrtf(wave_sum(x1 * x1 + x2 * x2) * (1.f / 128.f) + EPSF);
            const float y1 = x1 * r * (hh < 8 ? qw1 : kw1), y2 = x2 * r * (hh < 8 ? qw2 : kw2);
            const float o1 = y1 * cs - y2 * sn, o2 = y2 * cs + y1 * sn;
            p[d1] = (bfu)(cvtpk2(o1, 0.f) & 0xffffu); p[d2] = (bfu)(cvtpk2(o2, 0.f) & 0xffffu); }
    }
}

constexpr int PL_QS = 0, PL_KS = 17408, PL_KST = 34816, PL_VST = 53248, PL_AMAT = 71680, PL_TU = 104448, PL_SM = 141312;
__device__ __forceinline__ void prep_item(const Args& a, char* lds, int it) {
    int tid_o = threadIdx.x; asm volatile("" : "+v"(tid_o));
    const int tid = tid_o, lane = tid & 63, wave = __builtin_amdgcn_readfirstlane(tid >> 6);
    const int b = it / (GH * NCH), h = (it / NCH) % GH, cidx = it % NCH;
    const int rowbase = b * TOK + (cidx < 4 ? cidx * 64 : CTXL + (cidx - 4) * 64);
    const int seg_lo = b * TOK + (cidx < 4 ? 0 : CTXL), seg_hi = cidx < 4 ? b * TOK + CTXL : (b + 1) * TOK;
    const bfu* QKVG = (const bfu*)(a.ws + WS_QKVG); const bfu* GATES = (const bfu*)(a.ws + WS_GATES);
    unsigned char* item = a.ws + WS_FRAG + (size_t)it * ITEM_BYTES;
    bfu* QS = (bfu*)(lds + PL_QS); bfu* KS = (bfu*)(lds + PL_KS); bfu* KST = (bfu*)(lds + PL_KST); bfu* VST = (bfu*)(lds + PL_VST);
    float* AMAT = (float*)(lds + PL_AMAT); bfu* TUW = (bfu*)(lds + PL_TU); float* SM = (float*)(lds + PL_SM);
    const int hi = lane >> 5, n32 = lane & 31;
    {
        const float* conv_w = a.in[8];
        float cw[5][3][2];
#pragma unroll
        for (int j = 0; j < 5; ++j)
#pragma unroll
            for (int s = 0; s < 3; ++s) { const float* p = conv_w + j * 3072 + s * 1024 + h * 128 + 2 * lane; cw[j][s][0] = p[0]; cw[j][s][1] = p[1]; }
        unsigned raw[12][3];
        const int t0 = wave * 8;
#pragma unroll
        for (int rr = 0; rr < 12; ++rr) { const int rg = rowbase + t0 - 2 + rr; const bool ok = rg >= seg_lo && rg < seg_hi;
#pragma unroll
            for (int s = 0; s < 3; ++s) raw[rr][s] = ok ? *(const unsigned*)(QKVG + (size_t)rg * 3072 + s * 1024 + h * 128 + 2 * lane) : 0u; }
#pragma unroll
        for (int tt = 0; tt < 8; ++tt) { const int t = t0 + tt; float y[3][2];
#pragma unroll
            for (int s = 0; s < 3; ++s) { float a0 = 0.f, a1 = 0.f;
#pragma unroll
                for (int j = 0; j < 5; ++j) { a0 += bflo(raw[tt + j][s]) * cw[j][s][0]; a1 += bfhi(raw[tt + j][s]) * cw[j][s][1]; }
                y[s][0] = siluf(a0); y[s][1] = siluf(a1); }
            const float rq = rsqrtf(wave_sum(y[0][0] * y[0][0] + y[0][1] * y[0][1]) + EPSF) * 0.08838834764831845f;
            const float rk = rsqrtf(wave_sum(y[1][0] * y[1][0] + y[1][1] * y[1][1]) + EPSF);
            const unsigned qp = cvtpk2(y[0][0] * rq, y[0][1] * rq), kp = cvtpk2(y[1][0] * rk, y[1][1] * rk), vp = cvtpk2(y[2][0], y[2][1]);
            *(unsigned*)(QS + t * 136 + 2 * lane) = qp; *(unsigned*)(KS + t * 136 + 2 * lane) = kp;
            KST[(2 * lane) * 72 + t] = (bfu)(kp & 0xffffu); KST[(2 * lane + 1) * 72 + t] = (bfu)(kp >> 16);
            VST[(2 * lane) * 72 + t] = (bfu)(vp & 0xffffu); VST[(2 * lane + 1) * 72 + t] = (bfu)(vp >> 16); }
        if (lane < 16) { const int t = t0 + (lane & 7), dir = lane >> 3; const bfu* gp = GATES + (size_t)(rowbase + t) * 32 + dir * 8 + h;
            const float bl = bf2f(gp[0]), al = bf2f(gp[16]) + a.in[10][dir * 8 + h];
            const float sp = fmaxf(al, 0.f) + log1pf(__expf(-fabsf(al)));
            SM[dir * 64 + t] = 1.f / (1.f + __expf(-bl)); SM[128 + dir * 64 + t] = -__expf(a.in[9][dir * 8 + h]) * sp; }
    }
    __syncthreads();
    if (wave < 2) { const int dir = wave, t = dir ? 63 - lane : lane; float xg = SM[128 + dir * 64 + t];
#pragma unroll
        for (int off = 1; off < 64; off <<= 1) { const float y = __shfl_up(xg, off); if (lane >= off) xg += y; }
        const float gl = __shfl(xg, 63); const float eg = __expf(xg), ek = __expf(gl - xg);
        SM[256 + dir * 64 + t] = xg; SM[384 + dir * 64 + t] = eg;
        float* SC = (float*)(item + 32768 + dir * DIR_BYTES + 24576); SC[t] = eg; SC[64 + t] = ek; if (lane == 0) SC[128] = __expf(gl); }
#pragma unroll
    for (int p = 0; p < 4; ++p) { const int ci = tid + 512 * p, f = ci >> 6, ln = ci & 63, r = ln & 31, hh = ln >> 5; const bfu* src;
        if (f < 16) { const int mt = f >> 3, ks = f & 7; src = QS + (32 * mt + r) * 136 + 16 * ks + 8 * hh; }
        else { const int f2 = f - 16, mt = f2 >> 2, ks = f2 & 3; src = KST + (32 * mt + r) * 72 + 16 * ks + 8 * hh; }
        *(v4u*)(item + (size_t)ci * 16) = *(const v4u*)src; }
    __syncthreads();
    { const int which = wave >> 2, ti = (wave >> 1) & 1, tj = wave & 1; f32x16 c = {};
      if (which == 0) {
#pragma unroll
          for (int ks = 0; ks < 8; ++ks) { const v8s af = *(const v8s*)(KS + (32 * ti + n32) * 136 + 16 * ks + 8 * hi), bf = *(const v8s*)(KS + (32 * tj + n32) * 136 + 16 * ks + 8 * hi); c = MFMA32(af, bf, c); }
          const int j = 32 * tj + n32;
#pragma unroll 1
          for (int dir = 0; dir < 2; ++dir) { const float gj = SM[256 + dir * 64 + j]; const int lj = dir ? 63 - j : j;
#pragma unroll
              for (int r = 0; r < 16; ++r) { const int i = 32 * ti + crow_(r, hi); const bool cond = dir ? (j > i) : (j < i);
                  const float v = cond ? SM[dir * 64 + i] * c[r] * __expf(fminf(SM[256 + dir * 64 + i] - gj, 0.f)) : 0.f; const int li = dir ? 63 - i : i;
                  AMAT[dir * 4096 + li * 64 + lj] = v; } }
      } else {
#pragma unroll
          for (int ks = 0; ks < 8; ++ks) { const v8s af = *(const v8s*)(KS + (32 * tj + n32) * 136 + 16 * ks + 8 * hi), bf = *(const v8s*)(QS + (32 * ti + n32) * 136 + 16 * ks + 8 * hi); c = MFMA32(af, bf, c); }
          const int i = 32 * ti + n32;
#pragma unroll 1
          for (int dir = 0; dir < 2; ++dir) { const float gi = SM[256 + dir * 64 + i]; f32x16 p;
#pragma unroll
              for (int r = 0; r < 16; ++r) { const int j = 32 * tj + crow_(r, hi); const bool cond = dir ? (j >= i) : (j <= i);
                  p[r] = cond ? c[r] * __expf(fminf(gi - SM[256 + dir * 64 + j], 0.f)) : 0.f; }
              unsigned char* dst = item + 32768 + dir * DIR_BYTES + 16384;
              *(v8s*)(dst + ((ti * 4 + 2 * tj + 0) * 64 + lane) * 16) = pk4<0>(p); *(v8s*)(dst + ((ti * 4 + 2 * tj + 1) * 64 + lane) * 16) = pk4<8>(p); }
      } }
    __syncthreads();
    if (wave < 2) { const int dir = wave; const float* Am = AMAT + dir * 4096; float T[64];
#pragma unroll
        for (int i = 0; i < 64; ++i) T[i] = 0.f;
#pragma unroll
        for (int i = 0; i < 64; ++i) { float acc = (i == lane) ? 1.f : 0.f;
#pragma unroll
            for (int j4 = 0; j4 < (i + 3) / 4; ++j4) { const v4f av = *(const v4f*)(Am + i * 64 + 4 * j4);
                acc -= av.x * T[4 * j4]; acc -= av.y * T[4 * j4 + 1]; acc -= av.z * T[4 * j4 + 2]; acc -= av.w * T[4 * j4 + 3]; }
            T[i] = acc; asm volatile("" ::: "memory"); __builtin_amdgcn_sched_barrier(0); }
        const int oc = dir ? 63 - lane : lane; const float bc = SM[dir * 64 + oc], bw = -bc * SM[384 + dir * 64 + oc];
        bfu* TU = TUW + (dir * 2) * 4608; bfu* TW = TU + 4608;
#pragma unroll
        for (int i = 0; i < 64; ++i) { const int oi = dir ? 63 - i : i; const unsigned w = cvtpk2(T[i] * bc, T[i] * bw); TU[oi * 72 + oc] = (bfu)(w & 0xffffu); TW[oi * 72 + oc] = (bfu)(w >> 16); } }
    __syncthreads();
#pragma unroll
    for (int s = 0; s < 4; ++s) { const int q = wave * 4 + s, dir = q >> 4, prod = (q >> 3) & 1, mt = (q >> 2) & 1, nt = q & 3; f32x16 c = {};
        const bfu* TU = TUW + (dir * 2) * 4608; const bfu* TW = TU + 4608; unsigned char* dbase = item + 32768 + dir * DIR_BYTES;
        if (prod == 0) {
#pragma unroll
            for (int ks = 0; ks < 4; ++ks) { const v8s af = *(const v8s*)(TU + (32 * mt + n32) * 72 + 16 * ks + 8 * hi), bf = *(const v8s*)(VST + (32 * nt + n32) * 72 + 16 * ks + 8 * hi); c = MFMA32(af, bf, c); }
            v4u w0, w1; w0.x = cvtpk2(c[0], c[1]); w0.y = cvtpk2(c[2], c[3]); w0.z = cvtpk2(c[4], c[5]); w0.w = cvtpk2(c[6], c[7]);
            w1.x = cvtpk2(c[8], c[9]); w1.y = cvtpk2(c[10], c[11]); w1.z = cvtpk2(c[12], c[13]); w1.w = cvtpk2(c[14], c[15]);
            unsigned char* up = dbase + 25600 + ((nt * 2 + mt) * 64 + lane) * 32; *(v4u*)up = w0; *(v4u*)(up + 16) = w1;
        } else {
#pragma unroll
            for (int ks = 0; ks < 4; ++ks) { const v8s af = *(const v8s*)(KST + (32 * nt + n32) * 72 + 16 * ks + 8 * hi), bf = *(const v8s*)(TW + (32 * mt + n32) * 72 + 16 * ks + 8 * hi); c = MFMA32(af, bf, c); }
            *(v8s*)(dbase + ((mt * 8 + 2 * nt + 0) * 64 + lane) * 16) = pk4<0>(c); *(v8s*)(dbase + ((mt * 8 + 2 * nt + 1) * 64 + lane) * 16) = pk4<8>(c);
        } }
    __syncthreads();
}

__device__ __forceinline__ int cidx_of(int step, int dir) { return dir == 0 ? step : (step < 4 ? 3 - step : 263 - step); }
constexpr int SBUF = 32768 + 25600;
__device__ __forceinline__ void scan_item(const Args& a, char* lds, int sid) {
    const int tid = threadIdx.x, lane = tid & 63, wave = tid >> 6, hi = lane >> 5, n32 = lane & 31;
    const int b = sid >> 4, h = (sid >> 1) & 7, dir = sid & 1;
    const unsigned char* frag0 = a.ws + WS_FRAG + (size_t)((b * GH + h) * NCH) * ITEM_BYTES;
    bfu* OG = (bfu*)(a.ws + WS_QKVG) + (size_t)dir * NB * SEQ * 1024;
    const bool loader = wave >= 4; const int lt = tid - 256, wsl = wave;
    v4u st[15]; v4u ureg[4];
    f32x16 S0 = {}, S1 = {}, S2 = {}, S3 = {}; v8s Sb[8];
#pragma unroll
    for (int i = 0; i < 8; ++i) Sb[i] = (v8s){0, 0, 0, 0, 0, 0, 0, 0};
#define LD_ISSUE(step) do { const unsigned char* itp = frag0 + (size_t)cidx_of((step), dir) * ITEM_BYTES; const unsigned char* dp = itp + dir * DIR_BYTES; \
        _Pragma("unroll") for (int p = 0; p < 8; ++p) st[p] = *(const v4u*)(itp + p * 4096 + lt * 16); \
        _Pragma("unroll") for (int p = 8; p < 14; ++p) st[p] = *(const v4u*)(dp + p * 4096 + lt * 16); \
        if (lt < 64) st[14] = *(const v4u*)(dp + 14 * 4096 + lt * 16); } while (0)
#define LD_WRITE(bi) do { char* d = lds + (bi) * SBUF; _Pragma("unroll") for (int p = 0; p < 14; ++p) *(v4u*)(d + p * 4096 + lt * 16) = st[p]; if (lt < 64) *(v4u*)(d + 57344 + lt * 16) = st[14]; } while (0)
#define U_ISSUE(step) do { const unsigned char* up = frag0 + (size_t)cidx_of((step), dir) * ITEM_BYTES + 32768 + dir * DIR_BYTES + 25600 + ((wsl * 2) * 64 + lane) * 32; \
        ureg[0] = *(const v4u*)up; ureg[1] = *(const v4u*)(up + 16); ureg[2] = *(const v4u*)(up + 2048); ureg[3] = *(const v4u*)(up + 2048 + 16); } while (0)
    if (loader) { LD_ISSUE(0); LD_WRITE(0); LD_ISSUE(1); } else { U_ISSUE(0); }
    if (loader) {
        for (int step = 0; step < NCH; ++step) {
            __syncthreads();
            if (step + 1 < NCH) { LD_WRITE((step + 1) & 1); if (step + 2 < NCH) LD_ISSUE(step + 2); }
        }
    } else {
        for (int step = 0; step < NCH; ++step) {
            __syncthreads();
            {
            const char* bufp = lds + (step & 1) * SBUF; const int cidx = cidx_of(step, dir);
            f32x16 vn0, vn1, oq0 = {}, oq1 = {};
#pragma unroll
            for (int i = 0; i < 4; ++i) { vn0[2 * i] = bflo(ureg[0][i]); vn0[2 * i + 1] = bfhi(ureg[0][i]); vn0[8 + 2 * i] = bflo(ureg[1][i]); vn0[8 + 2 * i + 1] = bfhi(ureg[1][i]);
                vn1[2 * i] = bflo(ureg[2][i]); vn1[2 * i + 1] = bfhi(ureg[2][i]); vn1[8 + 2 * i] = bflo(ureg[3][i]); vn1[8 + 2 * i + 1] = bfhi(ureg[3][i]); }
            if (step + 1 < NCH) U_ISSUE(step + 1);
#pragma unroll
            for (int ks = 0; ks < 8; ++ks) {
                const v8s w0 = *(const v8s*)(bufp + 32768 + (ks) * 1024 + lane * 16), w1 = *(const v8s*)(bufp + 32768 + (8 + ks) * 1024 + lane * 16);
                const v8s q0 = *(const v8s*)(bufp + (ks) * 1024 + lane * 16), q1 = *(const v8s*)(bufp + (8 + ks) * 1024 + lane * 16);
                vn0 = MFMA32(w0, Sb[ks], vn0); vn1 = MFMA32(w1, Sb[ks], vn1); oq0 = MFMA32(q0, Sb[ks], oq0); oq1 = MFMA32(q1, Sb[ks], oq1); }
            const float* SC = (const float*)(bufp + 57344);
            f32x16 vs0, vs1;
#pragma unroll
            for (int q = 0; q < 4; ++q) { const v4f e0 = *(const v4f*)(SC + 64 + 8 * q + 4 * hi), e1 = *(const v4f*)(SC + 64 + 32 + 8 * q + 4 * hi);
                const v4f g0 = *(const v4f*)(SC + 8 * q + 4 * hi), g1 = *(const v4f*)(SC + 32 + 8 * q + 4 * hi);
#pragma unroll
                for (int j = 0; j < 4; ++j) { vs0[4 * q + j] = vn0[4 * q + j] * e0[j]; vs1[4 * q + j] = vn1[4 * q + j] * e1[j]; oq0[4 * q + j] *= g0[j]; oq1[4 * q + j] *= g1[j]; } }
            v8s Vb[4], Vs[4];
            Vb[0] = pk4<0>(vn0); Vb[1] = pk4<8>(vn0); Vb[2] = pk4<0>(vn1); Vb[3] = pk4<8>(vn1);
            Vs[0] = pk4<0>(vs0); Vs[1] = pk4<8>(vs0); Vs[2] = pk4<0>(vs1); Vs[3] = pk4<8>(vs1);
#pragma unroll
            for (int ks = 0; ks < 4; ++ks) { const v8s i0 = *(const v8s*)(bufp + 49152 + (ks) * 1024 + lane * 16), i1 = *(const v8s*)(bufp + 49152 + (4 + ks) * 1024 + lane * 16);
                oq0 = MFMA32(i0, Vb[ks], oq0); oq1 = MFMA32(i1, Vb[ks], oq1); }
            if (cidx >= 4) { bfu* op = OG + ((size_t)b * SEQ + (cidx - 4) * 64) * 1024 + h * 128 + 32 * wsl + n32;
#pragma unroll
                for (int r = 0; r < 16; ++r) { const int t = crow_(r, hi); op[(size_t)t * 1024] = (bfu)(cvtpk2(oq0[r], 0.f) & 0xffffu); op[(size_t)(32 + t) * 1024] = (bfu)(cvtpk2(oq1[r], 0.f) & 0xffffu); } }
            const float eL = SC[128];
#define S_UPD(SX, mt4) do { SX = SX * eL; _Pragma("unroll") for (int ks = 0; ks < 4; ++ks) { const v8s kf = *(const v8s*)(bufp + 16384 + ((mt4) * 4 + ks) * 1024 + lane * 16); SX = MFMA32(kf, Vs[ks], SX); } \
                Sb[2 * (mt4)] = pk4<0>(SX); Sb[2 * (mt4) + 1] = pk4<8>(SX); } while (0)
            S_UPD(S0, 0); S_UPD(S1, 1); S_UPD(S2, 2); S_UPD(S3, 3);
#undef S_UPD
            }
        }
    }
    __syncthreads();
#undef LD_ISSUE
#undef LD_WRITE
#undef U_ISSUE
}

__device__ __forceinline__ void phase5(const Args& a) {
    const int tid = threadIdx.x, lane = tid & 63, wave = tid >> 6;
    const int gw = blockIdx.x * 8 + wave, NGW = gridDim.x * 8;
    const bfu* OF = (const bfu*)(a.ws + WS_QKVG); const bfu* OB = OF + (size_t)NB * SEQ * 1024; bfu* Z = (bfu*)(a.ws + WS_Z);
    const float gw0 = a.in[11][2 * lane], gw1 = a.in[11][2 * lane + 1];
    for (int lr = gw; lr < NB * SEQ; lr += NGW) { const int b = lr / SEQ; const size_t zrow = (size_t)lr + CTXL * (b + 1);
#pragma unroll
        for (int hh = 0; hh < 8; ++hh) { const int c0 = hh * 128 + 2 * lane;
            const unsigned f = *(const unsigned*)(OF + (size_t)lr * 1024 + c0), g = *(const unsigned*)(OB + (size_t)lr * 1024 + c0);
            unsigned* zp = (unsigned*)(Z + zrow * 2048 + c0); const unsigned zz = *zp;
            const float o0 = bflo(f) + bflo(g), o1 = bfhi(f) + bfhi(g);
            const float r = rsqrtf(wave_sum(o0 * o0 + o1 * o1) * (1.f / 128.f) + EPSF);
            *zp = cvtpk2(o0 * r * gw0 * siluf(bflo(zz)), o1 * r * gw1 * siluf(bfhi(zz))); }
    }
}
__device__ __forceinline__ void phase7(const Args& a) {
    const int tid = threadIdx.x, lane = tid & 63, wave = tid >> 6;
    const int gw = blockIdx.x * 8 + wave, NGW = gridDim.x * 8; const float* fw = a.in[15];
    for (int row = gw; row < NB * SEQ; row += NGW) { v4f* p = (v4f*)(a.out + (size_t)row * DM); v4f v[8]; float ss = 0.f;
#pragma unroll
        for (int j = 0; j < 8; ++j) { v[j] = p[lane + 64 * j]; ss += (v[j].x * v[j].x + v[j].y * v[j].y) + (v[j].z * v[j].z + v[j].w * v[j].w); }
        const float rstd = rsqrtf(wave_sum(ss) * (1.f / DM) + EPSF);
#pragma unroll
        for (int j = 0; j < 8; ++j) { const v4f w = ((const v4f*)fw)[lane + 64 * j]; p[lane + 64 * j] = (v[j] * rstd) * w; }
    }
}

__global__ void __launch_bounds__(512, 2) mega_fwd(Args a) {
    extern __shared__ __attribute__((aligned(16))) unsigned char lds_[];
    char* lds = (char*)lds_;
    cg::grid_group grid = cg::this_grid();
    const int lo = a.ph_lo, hi = a.ph_hi;
    unsigned char* ws = a.ws;
#ifndef MK_SKIP
#define MK_SKIP 0
#endif
#define IN(k) (!((MK_SKIP >> (k)) & 1) && lo <= (k) && (k) < hi)
#define SEAM(k) do { if (IN(k) && IN((k) + 1)) grid.sync(); } while (0)
    if (IN(0)) { phase0(a, lds); } SEAM(0);
    if (IN(1)) { phase1(a); } SEAM(1);
    if (IN(2)) {
        pg8::Gemm g{(const pg8::bf16_t*)(ws + WS_H), (const pg8::bf16_t*)(ws + WS_WIN), MROWS, NPAD, DM}; pg8::StaticOrder S; S.init(MROWS, NPAD, (int)gridDim.x, (int)blockIdx.x);
        EpiIn E{(bfu*)(ws + WS_QKVG), (bfu*)(ws + WS_Z), (bfu*)(ws + WS_QKVA), (bfu*)(ws + WS_GATES)};
        pg8::gemm_phase<EpiIn, pg8::StaticOrder, true, true>((PG8_LAS unsigned char*)lds_, g, S, E);
    } SEAM(2);
    if (IN(3)) {
        phase3a(a);
        for (int it = blockIdx.x; it < NB * GH * NCH; it += gridDim.x) prep_item(a, lds, it);
    } SEAM(3);
    if (IN(4)) {
        if (blockIdx.x < 32) scan_item(a, lds, (int)blockIdx.x);
        unsigned* cnt = (unsigned*)(ws + WS_CNT); volatile int* slot = (volatile int*)(lds + LDS_BYTES - 16);
        for (;;) {
            __syncthreads();
            if (threadIdx.x == 0) *slot = (int)atomicAdd(cnt, 1u);
            __syncthreads();
            const int u = *slot; if (u >= 1024) break;
            const int bkv = u >> 8, b = bkv >> 1, kvh = bkv & 1, rem = u & 255, g4 = rem >> 6, qb = rem & 63, head = kvh * 4 + g4;
            const bfu* QKVA = (const bfu*)(ws + WS_QKVA);
            const bfu* Qp = QKVA + (size_t)(b * TOK + CTXL + qb * 256) * 1536 + head * 128;
            const bfu* Kp = QKVA + (size_t)(b * TOK) * 1536 + 1024 + kvh * 128; const bfu* Vp = Kp + 256;
            bfu* Zp = (bfu*)(ws + WS_Z) + (size_t)(b * TOK + CTXL + qb * 256) * 2048 + 1024 + head * 128;
            att::attn_dense_body<att::bf16>((const att::bf16*)Qp, (const att::bf16*)Kp, (const att::bf16*)Vp, Zp, TOK, lds);
        }
    } SEAM(4);
    if (IN(5)) { phase5(a); } SEAM(5);
    if (IN(6)) {
        pg8::Gemm g{(const pg8::bf16_t*)(ws + WS_Z), (const pg8::bf16_t*)(ws + WS_WOUT), NB * SEQ, DM, DM}; OutOrder S; S.so.init(NB * SEQ, DM, (int)gridDim.x, (int)blockIdx.x);
        EpiOut E{a.in[0], (const float*)(ws + WS_MOD), a.out};
        pg8::gemm_phase<EpiOut, OutOrder, true, true>((PG8_LAS unsigned char*)lds_, g, S, E);
    } SEAM(6);
    if (IN(7)) { phase7(a); }
#undef IN
#undef SEAM
}

extern "C" void kernel_launch(void* const* d_in, const int* in_sizes, int n_in, void* d_out, int out_size, void* d_ws, size_t ws_size, hipStream_t stream) {
    static int grid = 0;
    if (grid == 0) {
        if (n_in != 16 || out_size != NB * SEQ * DM || ws_size < WS_END) { fprintf(stderr, "kernel_launch: unexpected shapes (n_in %d out %d ws %zu need %zu)\n", n_in, out_size, ws_size, (size_t)WS_END); grid = -1; return; }
        int dev = 0, cus = 0, per_cu = 0;
        hipGetDevice(&dev); hipDeviceGetAttribute(&cus, hipDeviceAttributeMultiprocessorCount, dev);
        if (hipFuncSetAttribute((const void*)mega_fwd, hipFuncAttributeMaxDynamicSharedMemorySize, LDS_BYTES) != hipSuccess) { fprintf(stderr, "kernel_launch: hipFuncSetAttribute failed\n"); grid = -1; return; }
        if (hipOccupancyMaxActiveBlocksPerMultiprocessor(&per_cu, (const void*)mega_fwd, 512, LDS_BYTES) != hipSuccess || per_cu < 1) { fprintf(stderr, "kernel_launch: occupancy query says %d\n", per_cu); per_cu = 1; }
        (void)hipGetLastError();
        grid = cus * per_cu;
        fprintf(stderr, "kernel_launch: grid %d (cus %d x %d)\n", grid, cus, per_cu);
    }
    if (grid < 0) return;
    Args a{};
    for (int i = 0; i < 16; ++i) a.in[i] = (const float*)d_in[i];
    a.out = (float*)d_out; a.ws = (unsigned char*)d_ws;
#if MK_COOP
    a.ph_lo = 0; a.ph_hi = NPHASE;
    void* args[] = {&a};
    hipError_t e = hipLaunchCooperativeKernel((const void*)mega_fwd, dim3(grid), dim3(512), args, LDS_BYTES, stream);
    if (e != hipSuccess) fprintf(stderr, "kernel_launch: cooperative launch failed: %s (grid %d)\n", hipGetErrorString(e), grid);
#else
    for (int p = 0; p < NPHASE; ++p) { a.ph_lo = p; a.ph_hi = p + 1; hipLaunchKernelGGL(mega_fwd, dim3(grid), dim3(512), LDS_BYTES, stream, a); }
#endif
}
```

```cpp
#include <hip/hip_runtime.h>
#include <hip/hip_bf16.h>
#include <hip/hip_cooperative_groups.h>
#include <cstdio>
#include <cstdint>
namespace cg = cooperative_groups;

#ifndef ATT_PROBE_K
#define ATT_PROBE_K 1.f
#endif
#ifndef MK_COOP
#define MK_COOP 1
#endif

constexpr int DM = 2048, NB = 2, SEQ = 16384, CTXL = 256, TOK = SEQ + CTXL, MROWS = NB * TOK;
constexpr int HD = 128, GH = 8, NCH = TOK / 64;
constexpr int INC = 6688, NPAD = 6912;
constexpr float EPSF = 1e-6f;
constexpr int NPHASE = 9;

constexpr size_t WS_CNT = 0, WS_MOD = 4096, WS_WOUT = 131072;
constexpr size_t WS_GATES = WS_WOUT + (size_t)DM * DM * 2;
constexpr size_t WS_Z = WS_GATES + (size_t)MROWS * 32 * 2;
constexpr size_t WS_QKVA = WS_Z + (size_t)MROWS * 2048 * 2;
constexpr size_t WS_QKVG = WS_QKVA + (size_t)MROWS * 1536 * 2;
constexpr size_t WS_FRAG = WS_QKVG + (size_t)MROWS * 3072 * 2;
constexpr size_t DIR_BYTES = 16384 + 8192 + 1024 + 16384;
constexpr size_t ITEM_BYTES = 32768 + 2 * DIR_BYTES;
constexpr size_t WS_KC = WS_FRAG + (size_t)NB * GH * NCH * ITEM_BYTES;
constexpr size_t WS_VC = WS_KC + (size_t)NB * 2 * TOK * 128 * 2;
constexpr size_t WS_END = WS_VC + (size_t)NB * 2 * TOK * 128 * 2;
constexpr size_t OUT_H = 0, OUT_WIN = (size_t)MROWS * DM * 2;
static_assert(OUT_WIN + (size_t)NPAD * DM * 2 <= (size_t)NB * SEQ * DM * 4, "H + WinT fit in d_out");
static_assert((size_t)2 * NB * SEQ * 1024 * 2 <= (size_t)MROWS * 3072 * 2, "O_gdn fits over QKVG");

constexpr int LDS_BYTES = 151552;

typedef unsigned short bfu;
typedef float f32x16 __attribute__((ext_vector_type(16)));
typedef unsigned u32x2 __attribute__((ext_vector_type(2)));
__device__ __forceinline__ float bf2f(unsigned short u) { return __uint_as_float(((unsigned)u) << 16); }
__device__ __forceinline__ float bflo(unsigned w) { return __uint_as_float(w << 16); }
__device__ __forceinline__ float bfhi(unsigned w) { return __uint_as_float(w & 0xffff0000u); }
__device__ __forceinline__ float wave_sum(float v) {
#pragma unroll
    for (int o = 1; o < 64; o <<= 1) v += __shfl_xor(v, o);
    return v;
}
__device__ __forceinline__ float siluf(float x) { return x / (1.f + __expf(-x)); }

namespace pg8 {
#define PG8_LAS __attribute__((address_space(3)))
typedef unsigned short bf16_t;
typedef short bf16x8 __attribute__((ext_vector_type(8)));
typedef float f32x4 __attribute__((ext_vector_type(4)));
typedef unsigned u32x4 __attribute__((ext_vector_type(4)));
constexpr int BM = 256, BK = 64, HALF = 128, HTB = HALF * BK * 2  , STAGE_BYTES = 8 * HTB, NXCD = 8, WGM = 8;

__host__ __device__ __forceinline__ int lds_byte(int r, int c) { const int st = (r >> 4) * 2 + (c >> 5), rr = r & 15, cc = c & 31, ob = rr * 64 + cc * 2; return st * 1024 + (ob ^ (((ob >> 9) & 1) << 5)); }
__host__ __device__ __forceinline__ void stage_rc(int b, int& R, int& C) { const int st = b / 1024, sb = b % 1024, swz = sb ^ (((sb >> 9) & 1) << 5); R = (st >> 1) * 16 + swz / 64; C = (st & 1) * 32 + (swz % 64) / 2; }
__host__ __device__ __forceinline__ int perm32(int rho) { const int n = rho >> 4, i = rho & 15; return 8 * (i >> 2) + 4 * n + (i & 3); }

struct Unit { int pm, pn; };
struct Gemm { const bf16_t* A; const bf16_t* Bt; int M, N, K; };

struct StaticOrder {
    int nM, nN, nwg, G, c;
    __host__ __device__ void init(int M, int N, int G_, int c_) { nM = M / BM; nN = N / BM; nwg = nM * nN; G = G_; c = c_; }
    __host__ __device__ bool next(int i, Unit& u) const {
        const long L = (long)i * G + c; if (L >= nwg) return false;
        int wgid = (int)L; { const int q = nwg / NXCD, r = nwg % NXCD, xcd = wgid % NXCD, off = wgid / NXCD; wgid = (xcd < r ? xcd * (q + 1) : r * (q + 1) + (xcd - r) * q) + off; }
        const int nig = WGM * nN, gid = wgid / nig, fm = gid * WGM, gsz = (nM - fm) < WGM ? (nM - fm) : WGM;
        u.pm = fm + ((wgid % nig) % gsz); u.pn = (wgid % nig) / gsz; return true;
    }
    __device__ __forceinline__ void a_ready(const Unit&) const {}
    __device__ __forceinline__ void done(const Unit&) const {}
};

__device__ __forceinline__ unsigned cvt_pk_bf16(float lo, float hi) { unsigned r; asm volatile("v_cvt_pk_bf16_f32 %0, %1, %2" : "=v"(r) : "v"(lo), "v"(hi)); return r; }
template <class Epi, class Sched, bool ALIGN_EPI = false, bool SP2 = false>
__device__ __forceinline__ void gemm_phase(PG8_LAS unsigned char* lds, const Gemm g, const Sched& S, const Epi& E) {
    const int tid = threadIdx.x, wid = __builtin_amdgcn_readfirstlane(tid >> 6), lane = tid & 63, wr = wid >> 2, wc = wid & 3, fr = lane & 15, fq = lane >> 4;
    const int K = g.K, nt = K / BK;
    unsigned voffA[2], voffB[2];
#pragma unroll
    for (int i = 0; i < 2; ++i) { int R, C; stage_rc(tid * 16 + i * 8192, R, C); const int Rb = Epi::PERM ? ((R & ~31) + perm32(R & 31)) : R;
        voffA[i] = (unsigned)(R * K + C) * 2u; voffB[i] = (unsigned)(Rb * K + C) * 2u; }
    const size_t kstep = (size_t)(BK * 2);
    const size_t hstep = (size_t)HALF * K * 2;
    const size_t tstep = 2 * hstep;
    const unsigned ldsw = (unsigned)wid * 1024u;
    const int aoff = lds_byte(wr * 64 + fr, fq * 8), boff = lds_byte(wc * 32 + fr, fq * 8);
#define PG8_SA(b, h) (((b) * 2 + (h)) * HTB)
#define PG8_SB(b, h) ((4 + (b) * 2 + (h)) * HTB)
#define PG8_STAGE(bufoff, gbase, voff) do { _Pragma("unroll") for (int _i = 0; _i < 2; ++_i) \
        __builtin_amdgcn_global_load_lds((const unsigned*)((const char*)(gbase) + (voff)[_i]), (PG8_LAS unsigned*)(lds + (bufoff) + ldsw + _i * 8192), 16, 0, 0); } while (0)
#define PG8_LDA(dst, b, h) do { _Pragma("unroll") for (int m = 0; m < 4; ++m) _Pragma("unroll") for (int k = 0; k < 2; ++k) dst[m][k] = *(const PG8_LAS bf16x8*)(lds + PG8_SA(b, h) + aoff + m * 2048 + k * 1024); } while (0)
#define PG8_LDB(dst, b, h) do { _Pragma("unroll") for (int n = 0; n < 2; ++n) _Pragma("unroll") for (int k = 0; k < 2; ++k) dst[n][k] = *(const PG8_LAS bf16x8*)(lds + PG8_SB(b, h) + boff + n * 2048 + k * 1024); } while (0)
#define PG8_MMA(ai, bj, At, Bt) do { __builtin_amdgcn_s_setprio(1); _Pragma("unroll") for (int m = 0; m < 4; ++m) _Pragma("unroll") for (int n = 0; n < 2; ++n) _Pragma("unroll") for (int k = 0; k < 2; ++k) \
        acc[ai][bj][m][n] = __builtin_amdgcn_mfma_f32_16x16x32_bf16(Bt[n][k], At[m][k], acc[ai][bj][m][n], 0, 0, 0); __builtin_amdgcn_s_setprio(0); } while (0)
#define PG8_WAIT_V(n) asm volatile("s_waitcnt vmcnt(" #n ")" ::: "memory")
#define PG8_WAIT_L(n) asm volatile("s_waitcnt lgkmcnt(" #n ")" ::: "memory")
#define PG8_BAR __builtin_amdgcn_s_barrier()
#define PG8_SCHED __builtin_amdgcn_sched_barrier(0)
    Unit cur, nxt; int ui = 0;
    if (!S.next(0, cur)) return;
    f32x4 acc[2][2][4][2];
#pragma unroll
    for (int a = 0; a < 2; ++a)
#pragma unroll
        for (int b = 0; b < 2; ++b)
#pragma unroll
            for (int m = 0; m < 4; ++m)
#pragma unroll
                for (int n = 0; n < 2; ++n) acc[a][b][m][n] = (f32x4){0.f, 0.f, 0.f, 0.f};
    bf16x8 At[4][2], B0[2][2], B1[2][2];
    const char* cA = (const char*)g.A + (size_t)cur.pm * tstep; const char* cB = (const char*)g.Bt + (size_t)cur.pn * tstep;
    S.a_ready(cur);
    if constexpr (SP2) {
        PG8_STAGE(PG8_SB(0, 0), cB, voffB); PG8_STAGE(PG8_SB(0, 1), cB + hstep, voffB); PG8_STAGE(PG8_SA(0, 0), cA, voffA); PG8_STAGE(PG8_SA(0, 1), cA + hstep, voffA);
        if (wr == 1) PG8_BAR;
        PG8_WAIT_V(2); PG8_BAR;
        PG8_STAGE(PG8_SB(1, 0), cB + kstep, voffB); PG8_STAGE(PG8_SA(1, 0), cA + kstep, voffA); PG8_STAGE(PG8_SB(1, 1), cB + hstep + kstep, voffB);
        PG8_WAIT_V(6); PG8_BAR;
    } else {
        PG8_STAGE(PG8_SB(0, 0), cB, voffB); PG8_STAGE(PG8_SA(0, 0), cA, voffA); PG8_STAGE(PG8_SB(0, 1), cB + hstep, voffB); PG8_STAGE(PG8_SA(0, 1), cA + hstep, voffA);
        if (wr == 1) PG8_BAR;
        PG8_WAIT_V(4); PG8_BAR;
        PG8_STAGE(PG8_SB(1, 0), cB + kstep, voffB); PG8_STAGE(PG8_SA(1, 0), cA + kstep, voffA); PG8_STAGE(PG8_SB(1, 1), cB + hstep + kstep, voffB);
        PG8_WAIT_V(6); PG8_BAR;
    }
    for (;;) {
        const bool has_next = S.next(ui + 1, nxt);
        const char* nA = has_next ? (const char*)g.A + (size_t)nxt.pm * tstep : cA; const char* nB = has_next ? (const char*)g.Bt + (size_t)nxt.pn * tstep : cB;
        for (int t = 0; t < nt; t += 2) {
            const bool last = (t == nt - 2);
            const char* a1 = cA + (size_t)(t + 1) * kstep;
            const char* a2 = last ? nA : cA + (size_t)(t + 2) * kstep; const char* b2 = last ? nB : cB + (size_t)(t + 2) * kstep;
            const char* a3 = a2 + kstep; const char* b3 = b2 + kstep;
            if (last && has_next) S.a_ready(nxt);
            if constexpr (SP2) {
            PG8_LDB(B0, 0, 0); PG8_LDB(B1, 0, 1); PG8_SCHED; PG8_LDA(At, 0, 0); PG8_STAGE(PG8_SA(1, 1), a1 + hstep, voffA);
            PG8_WAIT_V(8); PG8_WAIT_L(0); PG8_BAR; PG8_MMA(0, 0, At, B0); PG8_MMA(0, 1, At, B1); PG8_BAR; PG8_SCHED;
            PG8_LDA(At, 0, 1); PG8_STAGE(PG8_SB(0, 0), b2, voffB); PG8_STAGE(PG8_SB(0, 1), b2 + hstep, voffB); PG8_STAGE(PG8_SA(0, 0), a2, voffA);
            PG8_WAIT_V(8); PG8_WAIT_L(0); PG8_BAR; PG8_MMA(1, 0, At, B0); PG8_MMA(1, 1, At, B1); PG8_BAR; PG8_SCHED;
            PG8_LDB(B0, 1, 0); PG8_LDB(B1, 1, 1); PG8_SCHED; PG8_LDA(At, 1, 0); PG8_STAGE(PG8_SA(0, 1), a2 + hstep, voffA);
            PG8_WAIT_V(8); PG8_WAIT_L(0); PG8_BAR; PG8_MMA(0, 0, At, B0); PG8_MMA(0, 1, At, B1); PG8_BAR; PG8_SCHED;
            PG8_LDA(At, 1, 1); PG8_STAGE(PG8_SB(1, 0), b3, voffB); PG8_STAGE(PG8_SB(1, 1), b3 + hstep, voffB); PG8_STAGE(PG8_SA(1, 0), a3, voffA);
            PG8_WAIT_V(8); PG8_WAIT_L(0); PG8_BAR; PG8_MMA(1, 0, At, B0); PG8_MMA(1, 1, At, B1); PG8_BAR; PG8_SCHED;
            } else {
            PG8_LDB(B0, 0, 0); PG8_SCHED; PG8_LDA(At, 0, 0); PG8_STAGE(PG8_SA(1, 1), a1 + hstep, voffA);
            PG8_WAIT_L(8); PG8_BAR; PG8_WAIT_L(0); PG8_MMA(0, 0, At, B0); PG8_BAR; PG8_SCHED;
            PG8_LDB(B1, 0, 1); PG8_STAGE(PG8_SB(0, 0), b2, voffB);
            PG8_BAR; PG8_WAIT_L(0); PG8_MMA(0, 1, At, B1); PG8_BAR;
            PG8_LDA(At, 0, 1); PG8_STAGE(PG8_SA(0, 0), a2, voffA);
            PG8_BAR; PG8_WAIT_L(0); PG8_MMA(1, 0, At, B0); PG8_BAR; PG8_SCHED;
            PG8_STAGE(PG8_SB(0, 1), b2 + hstep, voffB);
            PG8_WAIT_V(6); PG8_BAR; PG8_MMA(1, 1, At, B1); PG8_BAR;
            PG8_LDB(B0, 1, 0); PG8_SCHED; PG8_LDA(At, 1, 0); PG8_STAGE(PG8_SA(0, 1), a2 + hstep, voffA);
            PG8_WAIT_L(8); PG8_BAR; PG8_WAIT_L(0); PG8_MMA(0, 0, At, B0); PG8_BAR; PG8_SCHED;
            PG8_LDB(B1, 1, 1); PG8_STAGE(PG8_SB(1, 0), b3, voffB);
            PG8_BAR; PG8_WAIT_L(0); PG8_MMA(0, 1, At, B1); PG8_BAR;
            PG8_LDA(At, 1, 1); PG8_STAGE(PG8_SA(1, 0), a3, voffA);
            PG8_BAR; PG8_WAIT_L(0); PG8_MMA(1, 0, At, B0); PG8_BAR; PG8_SCHED;
            PG8_STAGE(PG8_SB(1, 1), b3 + hstep, voffB);
            PG8_WAIT_V(6); PG8_BAR; PG8_MMA(1, 1, At, B1); PG8_BAR;
            }
        }
        if constexpr (ALIGN_EPI) { if (wr == 0) PG8_BAR; }
        if constexpr (!Epi::AFTER_DRAIN) { E(acc, cur, wr, wc, fr, fq); S.done(cur); }
        if (!has_next) break;
#pragma unroll
        for (int a = 0; a < 2; ++a)
#pragma unroll
            for (int b = 0; b < 2; ++b)
#pragma unroll
                for (int m = 0; m < 4; ++m)
#pragma unroll
                    for (int n = 0; n < 2; ++n) acc[a][b][m][n] = (f32x4){0.f, 0.f, 0.f, 0.f};
        cur = nxt; cA = nA; cB = nB; ++ui;
        if constexpr (ALIGN_EPI) { if (wr == 1) PG8_BAR; }
    }
    PG8_WAIT_V(0);
    if constexpr (!ALIGN_EPI) { if (wr == 0) PG8_BAR; }
    PG8_BAR;
    if constexpr (Epi::AFTER_DRAIN) { E.fused(acc, cur, wr, wc, fr, fq, lds, wid, lane); S.done(cur); }
#undef PG8_SA
#undef PG8_SB
#undef PG8_STAGE
#undef PG8_LDA
#undef PG8_LDB
#undef PG8_MMA
#undef PG8_WAIT_V
#undef PG8_WAIT_L
#undef PG8_BAR
#undef PG8_SCHED
}
}

namespace att {
using bf16 = __hip_bfloat16;
constexpr int D = 128, NW = 8, QBLK = 32, KVBLK = 64;
constexpr float SCALE = 0.088388347648318440f;
constexpr float THR = 8.f;
constexpr int SDEPTH = 2;
constexpr int LDQ = 1536, LDK = 128, LDO = 2048;
constexpr size_t SHM_V = KVBLK * D * 2, SHM_K = KVBLK * D * 2, SHM_ATTN = 2 * SHM_V + 2 * SHM_K + NW * 64 * 4;
using bf16x8 = __attribute__((ext_vector_type(8))) short;
using s16x4  = __attribute__((ext_vector_type(4))) short;
using f32x16 = __attribute__((ext_vector_type(16))) float;
using f32x8  = __attribute__((ext_vector_type(8))) float;
using u32x4  = __attribute__((ext_vector_type(4))) unsigned;
#define KSWZ(row, colB) ((row) * 256 + ((colB) ^ (((row) & 7) << 4)))
#define SBAR() __builtin_amdgcn_sched_barrier(0)
__device__ __forceinline__ int crow(int r, int hi) { return (r & 3) + 8 * (r >> 2) + 4 * hi; }
__device__ __forceinline__ unsigned cvtpk(float lo, float hi) {
  unsigned r; asm volatile("v_cvt_pk_bf16_f32 %0, %1, %2" : "=v"(r) : "v"(lo), "v"(hi)); return r;
}
template <typename TIn> struct Stage;
template <> struct Stage<bf16>  { using T = bf16x8;
  __device__ static __forceinline__ T ld8(const bf16* p) { return *reinterpret_cast<const bf16x8*>(p); }
  __device__ static __forceinline__ bf16x8 tobf(T x) { return x; } };
template <> struct Stage<float> { using T = f32x8;
  __device__ static __forceinline__ T ld8(const float* p) { return *reinterpret_cast<const f32x8*>(p); }
  __device__ static __forceinline__ bf16x8 tobf(T x) {
    u32x4 w = {cvtpk(x[0], x[1]), cvtpk(x[2], x[3]), cvtpk(x[4], x[5]), cvtpk(x[6], x[7])}; return *reinterpret_cast<bf16x8*>(&w); } };

__device__ __forceinline__ void partialSM(f32x16& p0, f32x16& p1, float& m_reg, float& mn, float& alpha) {
  constexpr float C = SCALE * 1.4426950408889634f;
  float pmax = p0[0]; for (int r = 1; r < 16; ++r) pmax = fmaxf(pmax, p0[r]); for (int r = 0; r < 16; ++r) pmax = fmaxf(pmax, p1[r]);
  { auto rr = __builtin_amdgcn_permlane32_swap(__float_as_uint(pmax), __float_as_uint(pmax), false, false);
    pmax = fmaxf(__uint_as_float(rr[0]), __uint_as_float(rr[1])); }
  if (__builtin_expect(__all(pmax - m_reg <= THR / SCALE), 1)) { mn = m_reg; alpha = 1.f; }
  else { mn = fmaxf(m_reg, pmax); alpha = __builtin_amdgcn_exp2f((m_reg - mn) * C); m_reg = mn; }
  float mnC = -mn * C;
  for (int r = 0; r < 16; ++r) p0[r] = fmaf(p0[r], C, mnC); for (int r = 0; r < 16; ++r) p1[r] = fmaf(p1[r], C, mnC);
  for (int r = 0; r < 16; ++r) p0[r] = __builtin_amdgcn_exp2f(p0[r]);
}
__device__ __forceinline__ void finishSM(f32x16& p0, f32x16& p1, float alpha, float& l_reg, bf16x8& pa0, bf16x8& pa1, bf16x8& pa2, bf16x8& pa3) {
  for (int r = 0; r < 16; ++r) p1[r] = __builtin_amdgcn_exp2f(p1[r]);
  float ps = 0; for (int r = 0; r < 16; ++r) ps += p0[r]; for (int r = 0; r < 16; ++r) ps += p1[r];
  { auto rr = __builtin_amdgcn_permlane32_swap(__float_as_uint(ps), __float_as_uint(ps), false, false);
    ps = __uint_as_float(rr[0]) + __uint_as_float(rr[1]); }
  l_reg = l_reg * alpha + ps;
#define PK4(P, BASE, OUT) do { unsigned a0 = cvtpk(P[BASE + 0], P[BASE + 1]), a1 = cvtpk(P[BASE + 2], P[BASE + 3]);   \
    unsigned b0 = cvtpk(P[BASE + 4], P[BASE + 5]), b1 = cvtpk(P[BASE + 6], P[BASE + 7]);                              \
    auto r0 = __builtin_amdgcn_permlane32_swap(a0, b0, false, false); auto r1 = __builtin_amdgcn_permlane32_swap(a1, b1, false, false); \
    u32x4 w = {r0[0], r1[0], r0[1], r1[1]}; OUT = *reinterpret_cast<bf16x8*>(&w); } while (0)
  PK4(p0, 0, pa0); PK4(p0, 8, pa1); PK4(p1, 0, pa2); PK4(p1, 8, pa3);
#undef PK4
}
__device__ __forceinline__ void qkt(f32x16& p0, f32x16& p1, const bf16* Ks, const bf16x8* qr, int r32, int hi) {
  p0 = f32x16{}; p1 = f32x16{};
  for (int d0 = 0; d0 < 8; ++d0) { int cb = (d0 * 16 + hi * 8) * 2;
    bf16x8 b0 = *reinterpret_cast<const bf16x8*>((const char*)Ks + KSWZ(r32, cb));
    bf16x8 b1 = *reinterpret_cast<const bf16x8*>((const char*)Ks + KSWZ(32 + r32, cb));
    p0 = __builtin_amdgcn_mfma_f32_32x32x16_bf16(b0, qr[d0], p0, 0, 0, 0);
    p1 = __builtin_amdgcn_mfma_f32_32x32x16_bf16(b1, qr[d0], p1, 0, 0, 0); }
}
__device__ __forceinline__ int v_st(int k, int c) { const int kk = (k & ~0xC) | ((k & 4) << 1) | ((k & 8) >> 1); return ((kk >> 3) * 4 + (c >> 5)) * 512 + ((kk & 7) * 32 + (c & 31)) * 2; }
__device__ __forceinline__ int v_rd_base(int lane) { return ((lane & 3) << 3) | (((lane >> 2) & 3) << 6) | (((lane >> 4) & 1) << 5) | (((lane >> 5) & 1) << 8); }
constexpr int v_rd_off(int d0, int ks, int half) { return d0 * 512 + ks * 4096 + half * 2048; }
template <int OFF> __device__ __forceinline__ s16x4 tr_read(int vb) {
  s16x4 r; asm volatile("ds_read_b64_tr_b16 %0, %1 offset:%2" : "=&v"(r) : "v"(vb), "i"(OFF) : "memory"); return r;
}
template <int D0> __device__ __forceinline__ void pv_one(f32x16& od, int vb, bf16x8 pa0, bf16x8 pa1, bf16x8 pa2, bf16x8 pa3) {
  const s16x4 l0 = tr_read<v_rd_off(D0, 0, 0)>(vb), h0 = tr_read<v_rd_off(D0, 0, 1)>(vb), l1 = tr_read<v_rd_off(D0, 1, 0)>(vb), h1 = tr_read<v_rd_off(D0, 1, 1)>(vb);
  const s16x4 l2 = tr_read<v_rd_off(D0, 2, 0)>(vb), h2 = tr_read<v_rd_off(D0, 2, 1)>(vb), l3 = tr_read<v_rd_off(D0, 3, 0)>(vb), h3 = tr_read<v_rd_off(D0, 3, 1)>(vb);
  asm volatile("s_waitcnt lgkmcnt(0)" ::: "memory"); SBAR();
#define PK(L, H) (bf16x8){L[0], L[1], L[2], L[3], H[0], H[1], H[2], H[3]}
  od = __builtin_amdgcn_mfma_f32_32x32x16_bf16(pa0, PK(l0, h0), od, 0, 0, 0);
  od = __builtin_amdgcn_mfma_f32_32x32x16_bf16(pa1, PK(l1, h1), od, 0, 0, 0);
  od = __builtin_amdgcn_mfma_f32_32x32x16_bf16(pa2, PK(l2, h2), od, 0, 0, 0);
  od = __builtin_amdgcn_mfma_f32_32x32x16_bf16(pa3, PK(l3, h3), od, 0, 0, 0);
#undef PK
}
__device__ __forceinline__ void pv_d0(f32x16* o, int vb, bf16x8 pa0, bf16x8 pa1, bf16x8 pa2, bf16x8 pa3) {
  pv_one<0>(o[0], vb, pa0, pa1, pa2, pa3); pv_one<1>(o[1], vb, pa0, pa1, pa2, pa3); pv_one<2>(o[2], vb, pa0, pa1, pa2, pa3); pv_one<3>(o[3], vb, pa0, pa1, pa2, pa3);
}

template <typename TQ>
__device__ __forceinline__ void attn_dense_body(const TQ* __restrict__ Qb, const bf16* __restrict__ Kh, const bf16* __restrict__ Vh,
                                                unsigned short* Ob, int seq, char* lds) {
  using St = Stage<bf16>; using SQ = Stage<TQ>;
  int tid_o = threadIdx.x; asm volatile("" : "+v"(tid_o));
  const int tid = tid_o, wid = tid >> 6, lane = tid & 63, r32 = lane & 31, hi = lane >> 5;
  bf16* V_lds = (bf16*)lds; bf16* K_lds = (bf16*)(lds + 2 * SHM_V);
  float* ws = (float*)(lds + 2 * SHM_V + 2 * SHM_K) + wid * 64; float* li_l = ws; float* al_l = ws + 32;
  float m_reg = -1e30f, l_reg = 0; f32x16 o[4] = {}; bf16x8 qr[8];
  const TQ* Qw = Qb + (long)(wid * QBLK + r32) * LDQ + hi * 8;
#pragma unroll
  for (int d0 = 0; d0 < 8; ++d0) qr[d0] = SQ::tobf(SQ::ld8(Qw + d0 * 16));
  const int sr = tid >> 4, sc = (tid & 15) * 8, vst0 = v_st(sr, sc), vst1 = v_st(32 + sr, sc);
  const int vb0 = (int)(uintptr_t)V_lds + v_rd_base(lane);
  struct { typename St::T vs0, vs1, ks0, ks1; } sr_[SDEPTH];
#define SLOAD(i, k0) do { sr_[i].vs0 = St::ld8(&Vh[(long)((k0) + sr) * LDK + sc]); sr_[i].vs1 = St::ld8(&Vh[(long)((k0) + 32 + sr) * LDK + sc]); \
    sr_[i].ks0 = St::ld8(&Kh[(long)((k0) + sr) * LDK + sc]); sr_[i].ks1 = St::ld8(&Kh[(long)((k0) + 32 + sr) * LDK + sc]); } while (0)
#define SWRITE(b, i) do { *(bf16x8*)((char*)V_lds + (b) * SHM_V + vst0) = St::tobf(sr_[i].vs0);          \
    *(bf16x8*)((char*)V_lds + (b) * SHM_V + vst1) = St::tobf(sr_[i].vs1); int kc = sc * 2;               \
    *(bf16x8*)((char*)K_lds + (b) * SHM_K + KSWZ(sr, kc)) = St::tobf(sr_[i].ks0);                       \
    *(bf16x8*)((char*)K_lds + (b) * SHM_K + KSWZ(32 + sr, kc)) = St::tobf(sr_[i].ks1); } while (0)
#define SWAIT() do { if constexpr (SDEPTH == 2) asm volatile("s_waitcnt vmcnt(4)" ::: "memory"); else asm volatile("s_waitcnt vmcnt(0)" ::: "memory"); } while (0)
#define RESC(a) do { if (__any((a) < 1.f)) { if (hi == 0) al_l[r32] = (a); asm volatile("s_waitcnt lgkmcnt(0)" ::: "memory"); \
    for (int d = 0; d < 4; ++d) for (int r = 0; r < 16; ++r) o[d][r] *= al_l[crow(r, hi)]; } } while (0)
  f32x16 pA0, pA1, pB0, pB1; float mnA, mnB, alA, alB; bf16x8 pa0, pa1, pa2, pa3; const int NT = seq / KVBLK;
  constexpr int SE = 0, SO = SDEPTH - 1;
  SLOAD(SE, 0); asm volatile("s_waitcnt vmcnt(0)" ::: "memory"); SWRITE(0, SE); __syncthreads();
  qkt(pA0, pA1, K_lds, qr, r32, hi); partialSM(pA0, pA1, m_reg, mnA, alA);
  SLOAD(SO, KVBLK); if constexpr (SDEPTH == 2) { if (2 < NT) SLOAD(SE, 2 * KVBLK); }
  SWAIT(); SWRITE(1, SO); __syncthreads();
  for (int j = 1; j + 1 < NT; j += 2) {
    SBAR(); qkt(pB0, pB1, (bf16*)((char*)K_lds + SHM_K), qr, r32, hi);
    finishSM(pA0, pA1, alA, l_reg, pa0, pa1, pa2, pa3); SBAR();
    SLOAD(SO, (j + SDEPTH) * KVBLK); SBAR();
    pv_d0(o, vb0, pa0, pa1, pa2, pa3); partialSM(pB0, pB1, m_reg, mnB, alB);
    __syncthreads(); SWAIT(); SWRITE(0, SE);
    RESC(alB); __syncthreads();
    SBAR(); qkt(pA0, pA1, K_lds, qr, r32, hi);
    finishSM(pB0, pB1, alB, l_reg, pa0, pa1, pa2, pa3); SBAR();
    if (SDEPTH == 1 || j + 3 < NT) SLOAD(SE, (j + 1 + SDEPTH) * KVBLK); SBAR();
    pv_d0(o, vb0 + (int)SHM_V, pa0, pa1, pa2, pa3); partialSM(pA0, pA1, m_reg, mnA, alA);
    __syncthreads(); SWAIT(); SWRITE(1, SO);
    RESC(alA); __syncthreads();
  }
  SBAR(); qkt(pB0, pB1, (bf16*)((char*)K_lds + SHM_K), qr, r32, hi);
  finishSM(pA0, pA1, alA, l_reg, pa0, pa1, pa2, pa3); SBAR();
  pv_d0(o, vb0, pa0, pa1, pa2, pa3); partialSM(pB0, pB1, m_reg, mnB, alB);
  __syncthreads(); RESC(alB);
  finishSM(pB0, pB1, alB, l_reg, pa0, pa1, pa2, pa3); SBAR();
  pv_d0(o, vb0 + (int)SHM_V, pa0, pa1, pa2, pa3);
  if (hi == 0) li_l[r32] = l_reg; asm volatile("s_waitcnt lgkmcnt(0)" ::: "memory");
  float rli[16];
#pragma unroll
  for (int r = 0; r < 16; ++r) rli[r] = __builtin_amdgcn_rcpf(li_l[crow(r, hi)]);
  unsigned short* Ow = Ob + (long)(wid * QBLK) * LDO;
#pragma unroll
  for (int r = 0; r < 16; ++r) { int orow = crow(r, hi);
#pragma unroll
    for (int d0 = 0; d0 < 4; ++d0) { unsigned short* p = Ow + (long)orow * LDO + d0 * 32 + r32; const float z = __uint_as_float(((unsigned)*p) << 16);
      const float v = ATT_PROBE_K * o[d0][r] * rli[r] * z / (1.f + __expf(-z)); *p = (unsigned short)(cvtpk(v, 0.f) & 0xffffu); } }
#undef SLOAD
#undef SWRITE
#undef SWAIT
#undef RESC
}

}

typedef short v8s __attribute__((ext_vector_type(8)));
typedef float v4f __attribute__((ext_vector_type(4)));
typedef unsigned v4u __attribute__((ext_vector_type(4)));
#define MFMA32(a, b, c) __builtin_amdgcn_mfma_f32_32x32x16_bf16((a), (b), (c), 0, 0, 0)
typedef float f32x2_t __attribute__((ext_vector_type(2))); typedef __bf16 bf16x2_t __attribute__((ext_vector_type(2)));
__device__ __forceinline__ unsigned cvtpk2(float lo, float hi) { f32x2_t v = {lo, hi}; bf16x2_t b = __builtin_convertvector(v, bf16x2_t); return __builtin_bit_cast(unsigned, b); }
__device__ __forceinline__ int crow_(int r, int hi) { return (r & 3) + 8 * (r >> 2) + 4 * hi; }
template <int BASE> __device__ __forceinline__ v8s pk4(const f32x16& P) {
    const unsigned a0 = cvtpk2(P[BASE + 0], P[BASE + 1]), a1 = cvtpk2(P[BASE + 2], P[BASE + 3]);
    const unsigned b0 = cvtpk2(P[BASE + 4], P[BASE + 5]), b1 = cvtpk2(P[BASE + 6], P[BASE + 7]);
    auto r0 = __builtin_amdgcn_permlane32_swap(a0, b0, false, false); auto r1 = __builtin_amdgcn_permlane32_swap(a1, b1, false, false);
    v4u w = {r0[0], r1[0], r0[1], r1[1]}; return __builtin_bit_cast(v8s, w);
}

struct Args { const float* in[16]; float* out; unsigned char* ws; int ph_lo, ph_hi; };

__device__ __forceinline__ void transpose_item(const float* __restrict__ W, int N, bfu* __restrict__ WT, int K, int k0, int n0, int dn0, float* scr, int lane) {
#pragma unroll 8
    for (int i = 0; i < 32; ++i) { const int kk = 2 * i + (lane >> 5); scr[kk * 33 + (lane & 31)] = W[(size_t)(k0 + kk) * N + n0 + (lane & 31)]; }
    asm volatile("s_waitcnt lgkmcnt(0)" ::: "memory");
    const int c = lane & 7;
#pragma unroll
    for (int j = 0; j < 4; ++j) { const int n = (lane >> 3) + 8 * j; const float* s = scr + (8 * c) * 33 + n;
        v4u o; o.x = cvtpk2(s[0 * 33], s[1 * 33]); o.y = cvtpk2(s[2 * 33], s[3 * 33]); o.z = cvtpk2(s[4 * 33], s[5 * 33]); o.w = cvtpk2(s[6 * 33], s[7 * 33]);
        *(v4u*)(WT + (size_t)(dn0 + n) * K + k0 + 8 * c) = o; }
    asm volatile("s_waitcnt lgkmcnt(0)" ::: "memory");
}
__device__ __forceinline__ void phase0(const Args& a, char* lds) {
    const int tid = threadIdx.x, lane = tid & 63, wave = tid >> 6;
    unsigned char* ws = a.ws;
    if (blockIdx.x == 0 && tid == 0) { ((unsigned*)(ws + WS_CNT))[0] = 0u; }
    float* sv = (float*)lds; float* red = (float*)(lds + 24576);
    const float* c = a.in[1]; const float* cc = a.in[3]; const float* w_ada = a.in[4]; const float* b_ada = a.in[5];
    float* MOD = (float*)(ws + WS_MOD);
    if (blockIdx.x < 192) {
        for (int i = tid; i < 3 * 2048; i += 512) { const float v = i < 4096 ? c[i] : cc[i - 4096]; sv[i] = siluf(v); }
        __syncthreads();
        for (int cgp = blockIdx.x; cgp < 192; cgp += gridDim.x) {
            const int sub = tid & 7, rg = tid >> 3;
            v4f acc0 = {0.f, 0.f, 0.f, 0.f}, acc1 = acc0, acc2 = acc0;
            const float* wp = w_ada + (size_t)(rg * 32) * 6144 + cgp * 32 + sub * 4;
#pragma unroll 8
            for (int rr = 0; rr < 32; ++rr) { const v4f w = *(const v4f*)(wp + (size_t)rr * 6144); const int k = rg * 32 + rr; acc0 += sv[k] * w; acc1 += sv[2048 + k] * w; acc2 += sv[4096 + k] * w; }
            float* rp = red + rg * 96 + sub * 4;
            *(v4f*)(rp) = acc0; *(v4f*)(rp + 32) = acc1; *(v4f*)(rp + 64) = acc2;
            __syncthreads();
            if (tid < 96) { float s = 0.f; for (int g = 0; g < 64; ++g) s += red[g * 96 + tid]; const int v = tid >> 5, cix = tid & 31; MOD[v * 6144 + cgp * 32 + cix] = s + b_ada[cgp * 32 + cix]; }
            __syncthreads();
        }
    }
    __syncthreads();
    float* scr = (float*)(lds + wave * 8448);
    const int gw = blockIdx.x * 8 + wave, NGW = gridDim.x * 8;
    const float* w_in = a.in[7]; const float* w_out = a.in[14];
    bfu* WinT = (bfu*)((unsigned char*)a.out + OUT_WIN); bfu* WoutT = (bfu*)(ws + WS_WOUT);
    constexpr int I_IN = 32 * 209, I_OUT = 32 * 64;
    for (int it = gw; it < I_IN + I_OUT; it += NGW) {
        if (it < I_IN) { const int kb = it / 209, nb = it % 209, n0 = nb * 32;
            const int dn0 = n0 < 4096 ? n0 : (n0 < 4128 ? n0 + 2560 : (n0 < 5664 ? n0 + 992 : n0 - 1568));
            transpose_item(w_in, INC, WinT, DM, kb * 64, n0, dn0, scr, lane);
        } else { const int r = it - I_IN, kb = r / 64, nb = r % 64; transpose_item(w_out, DM, WoutT, DM, kb * 64, nb * 32, nb * 32, scr, lane); }
    }
    { v4u z = {0u, 0u, 0u, 0u}; v4u* pz = (v4u*)(WinT + (size_t)INC * DM); const int n16 = (NPAD - INC) * DM * 2 / 16;
      for (int i = blockIdx.x * 512 + tid; i < n16; i += gridDim.x * 512) pz[i] = z; }
}

__device__ __forceinline__ void phase1(const Args& a) {
    const int tid = threadIdx.x, lane = tid & 63, wave = tid >> 6;
    const int gw = blockIdx.x * 8 + wave, NGW = gridDim.x * 8;
    const float* x = a.in[0]; const float* ctx = a.in[2]; const float* nw = a.in[6];
    const float* MOD = (const float*)(a.ws + WS_MOD); bfu* H = (bfu*)((unsigned char*)a.out + OUT_H);
    for (int row = gw; row < MROWS; row += NGW) {
        const int b = row / TOK, tl = row - b * TOK;
        const float* src = tl < CTXL ? ctx + ((size_t)b * CTXL + tl) * DM : x + ((size_t)b * SEQ + (tl - CTXL)) * DM;
        const float* shift = MOD + (tl < CTXL ? 2 : b) * 6144; const float* scale = shift + 2048;
        v4f v[8]; float ss = 0.f;
#pragma unroll
        for (int j = 0; j < 8; ++j) { v[j] = ((const v4f*)src)[lane + 64 * j]; ss += (v[j].x * v[j].x + v[j].y * v[j].y) + (v[j].z * v[j].z + v[j].w * v[j].w); }
        const float rstd = rsqrtf(wave_sum(ss) * (1.f / DM) + EPSF);
#pragma unroll
        for (int j = 0; j < 8; ++j) { const int col = (lane + 64 * j) * 4; const v4f w = *(const v4f*)(nw + col), sc = *(const v4f*)(scale + col), sh = *(const v4f*)(shift + col);
            const v4f y = (v[j] * rstd) * w * (1.f + sc) + sh; u32x2 o; o.x = cvtpk2(y.x, y.y); o.y = cvtpk2(y.z, y.w);
            *(u32x2*)(H + (size_t)row * DM + col) = o; }
    }
}

struct EpiIn {
    static constexpr bool PERM = true, AFTER_DRAIN = false;
    bfu* qkvg; bfu* z; bfu* qkva; bfu* gates;
    __device__ __forceinline__ void operator()(const pg8::f32x4 (&acc)[2][2][4][2], const pg8::Unit& u, int wr, int wc, int fr, int fq) const {
        bfu* base; int ld, colb; const int pn = u.pn;
        if (pn < 12) { base = qkvg; ld = 3072; colb = pn * 256; } else if (pn < 20) { base = z; ld = 2048; colb = (pn - 12) * 256; }
        else if (pn < 26) { base = qkva; ld = 1536; colb = (pn - 20) * 256; } else { base = gates; ld = 32; colb = 0; }
        const bool gt = pn >= 26;
        const int row0 = u.pm * 256 + wr * 64 + fr, col0 = colb + wc * 32 + 8 * fq;
#pragma unroll
        for (int ai = 0; ai < 2; ++ai)
#pragma unroll
            for (int m = 0; m < 4; ++m) { bfu* rowp = base + (size_t)(row0 + ai * 128 + m * 16) * ld + col0;
#pragma unroll
                for (int bj = 0; bj < 2; ++bj) { const pg8::f32x4 v0 = acc[ai][bj][m][0], v1 = acc[ai][bj][m][1];
                    v4u w; w.x = cvtpk2(v0[0], v0[1]); w.y = cvtpk2(v0[2], v0[3]); w.z = cvtpk2(v1[0], v1[1]); w.w = cvtpk2(v1[2], v1[3]);
                    if (!gt) *(v4u*)(rowp + bj * 128) = w; else if (bj == 0 && wc == 0) *(v4u*)(rowp) = w; } }
    }
};
struct EpiOut {
    static constexpr bool PERM = false, AFTER_DRAIN = false;
    const float* x; const float* mod; float* out;
    __device__ __forceinline__ void operator()(const pg8::f32x4 (&acc)[2][2][4][2], const pg8::Unit& u, int wr, int wc, int fr, int fq) const {
        const int b = u.pm >= 65 ? 1 : 0; const float* gate = mod + b * 6144 + 4096;
        const int col0 = u.pn * 256 + wc * 32 + 4 * fq;
#pragma unroll
        for (int ai = 0; ai < 2; ++ai)
#pragma unroll
            for (int m = 0; m < 4; ++m) { const int row = u.pm * 256 + ai * 128 + wr * 64 + m * 16 + fr; const size_t off = (size_t)(row - 256 * (b + 1)) * DM + col0;
#pragma unroll
                for (int bj = 0; bj < 2; ++bj)
#pragma unroll
                    for (int n = 0; n < 2; ++n) { const int cc = bj * 128 + n * 16; const v4f g = *(const v4f*)(gate + col0 + cc), xv = *(const v4f*)(x + off + cc);
                        const pg8::f32x4 av = acc[ai][bj][m][n]; v4f o; o.x = xv.x + g.x * av[0]; o.y = xv.y + g.y * av[1]; o.z = xv.z + g.z * av[2]; o.w = xv.w + g.w * av[3];
                        *(v4f*)(out + off + cc) = o; } }
    }
};
struct OutOrder { pg8::StaticOrder so;
    __device__ __forceinline__ bool next(int i, pg8::Unit& u) const { if (!so.next(i, u)) return false; u.pm = u.pm < 64 ? u.pm + 1 : u.pm + 2; return true; }
    __device__ __forceinline__ void a_ready(const pg8::Unit&) const {}
    __device__ __forceinline__ void done(const pg8::Unit&) const {}
};

struct InOrder { pg8::StaticOrder so; int limit, mode;
    __device__ __forceinline__ bool next(int i, pg8::Unit& u) const { if ((long)i * so.G + so.c >= limit) return false; if (!so.next(i, u)) return false; u.pn = mode ? u.pn + 12 : (u.pn < 12 ? u.pn : 26); return true; }
    __device__ __forceinline__ void a_ready(const pg8::Unit&) const {}
    __device__ __forceinline__ void done(const pg8::Unit&) const {}
};
__device__ __forceinline__ void phase3a(const Args& a) {
    const int tid = threadIdx.x, lane = tid & 63, wave = tid >> 6;
    const int gw = blockIdx.x * 8 + wave, NGW = gridDim.x * 8;
    bfu* QKVA = (bfu*)(a.ws + WS_QKVA); const float* qnw = a.in[12]; const float* knw = a.in[13];
    const int ax = lane >> 5, i = lane & 31, d1 = ax * 64 + i, d2 = d1 + 32;
    const float inv = exp2f(-(float)i * (13.287712379549449f / 32.f));
    const float qw1 = qnw[d1], qw2 = qnw[d2], kw1 = knw[d1], kw2 = knw[d2];
    for (int row = gw; row < MROWS; row += NGW) {
        const int b = row / TOK, tl = row - b * TOK; const bool isctx = tl < CTXL; const int t = tl - CTXL;
        float cs = 1.f, sn = 0.f;
        if (!isctx) { const float pos = (float)(ax == 0 ? (t >> 6) : (t & 63)); const float ang = pos * inv; float rev = ang * 0.15915494309189535f; rev -= floorf(rev);
            sn = __builtin_amdgcn_sinf(rev); cs = __builtin_amdgcn_cosf(rev); }
        bfu* base = QKVA + (size_t)row * 1536;
        { bfu* VC = (bfu*)(a.ws + WS_VC);
#pragma unroll
          for (int kv = 0; kv < 2; ++kv) *(unsigned*)(VC + ((size_t)(b * 2 + kv) * TOK + tl) * 128 + 2 * lane) = *(const unsigned*)(base + 1280 + kv * 128 + 2 * lane); }
#pragma unroll
        for (int hh = 0; hh < 10; ++hh) { bfu* p = base + hh * 128;
            const float x1 = bf2f(p[d1]), x2 = bf2f(p[d2]);
            const float r = rsqrtf(wave_sum(x1 * x1 + x2 * x2) * (1.f / 128.f) + EPSF);
            const float y1 = x1 * r * (hh < 8 ? qw1 : kw1), y2 = x2 * r * (hh < 8 ? qw2 : kw2);
            const float o1 = y1 * cs - y2 * sn, o2 = y2 * cs + y1 * sn;
            bfu* q = hh < 8 ? p : (bfu*)(a.ws + WS_KC) + ((size_t)(b * 2 + (hh - 8)) * TOK + tl) * 128;
            q[d1] = (bfu)(cvtpk2(o1, 0.f) & 0xffffu); q[d2] = (bfu)(cvtpk2(o2, 0.f) & 0xffffu); }
    }
}

constexpr int PL_QS = 0, PL_KS = 17408, PL_KST = 34816, PL_VST = 53248, PL_AMAT = 71680, PL_TU = 104448, PL_SM = 141312;
__device__ __forceinline__ void prep_item(const Args& a, char* lds, int it) {
    int tid_o = threadIdx.x; asm volatile("" : "+v"(tid_o));
    const int tid = tid_o, lane = tid & 63, wave = __builtin_amdgcn_readfirstlane(tid >> 6);
    const int b = it / (GH * NCH), h = (it / NCH) % GH, cidx = it % NCH;
    const int rowbase = b * TOK + (cidx < 4 ? cidx * 64 : CTXL + (cidx - 4) * 64);
    const int seg_lo = b * TOK + (cidx < 4 ? 0 : CTXL), seg_hi = cidx < 4 ? b * TOK + CTXL : (b + 1) * TOK;
    const bfu* QKVG = (const bfu*)(a.ws + WS_QKVG); const bfu* GATES = (const bfu*)(a.ws + WS_GATES);
    unsigned char* item = a.ws + WS_FRAG + (size_t)it * ITEM_BYTES;
    bfu* QS = (bfu*)(lds + PL_QS); bfu* KS = (bfu*)(lds + PL_KS); bfu* KST = (bfu*)(lds + PL_KST); bfu* VST = (bfu*)(lds + PL_VST);
    float* AMAT = (float*)(lds + PL_AMAT); bfu* TUW = (bfu*)(lds + PL_TU); float* SM = (float*)(lds + PL_SM);
    const int hi = lane >> 5, n32 = lane & 31;
    {
        const float* conv_w = a.in[8];
        float cw[5][3][2];
#pragma unroll
        for (int j = 0; j < 5; ++j)
#pragma unroll
            for (int s = 0; s < 3; ++s) { const float* p = conv_w + j * 3072 + s * 1024 + h * 128 + 2 * lane; cw[j][s][0] = p[0]; cw[j][s][1] = p[1]; }
        unsigned raw[12][3];
        const int t0 = wave * 8;
#pragma unroll
        for (int rr = 0; rr < 12; ++rr) { const int rg = rowbase + t0 - 2 + rr; const bool ok = rg >= seg_lo && rg < seg_hi;
#pragma unroll
            for (int s = 0; s < 3; ++s) raw[rr][s] = ok ? *(const unsigned*)(QKVG + (size_t)rg * 3072 + s * 1024 + h * 128 + 2 * lane) : 0u; }
#pragma unroll
        for (int tt = 0; tt < 8; ++tt) { const int t = t0 + tt; float y[3][2];
#pragma unroll
            for (int s = 0; s < 3; ++s) { float a0 = 0.f, a1 = 0.f;
#pragma unroll
                for (int j = 0; j < 5; ++j) { a0 += bflo(raw[tt + j][s]) * cw[j][s][0]; a1 += bfhi(raw[tt + j][s]) * cw[j][s][1]; }
                y[s][0] = siluf(a0); y[s][1] = siluf(a1); }
            const float rq = rsqrtf(wave_sum(y[0][0] * y[0][0] + y[0][1] * y[0][1]) + EPSF) * 0.08838834764831845f;
            const float rk = rsqrtf(wave_sum(y[1][0] * y[1][0] + y[1][1] * y[1][1]) + EPSF);
            const unsigned qp = cvtpk2(y[0][0] * rq, y[0][1] * rq), kp = cvtpk2(y[1][0] * rk, y[1][1] * rk), vp = cvtpk2(y[2][0], y[2][1]);
            *(unsigned*)(QS + t * 136 + 2 * lane) = qp; *(unsigned*)(KS + t * 136 + 2 * lane) = kp;
            KST[(2 * lane) * 72 + t] = (bfu)(kp & 0xffffu); KST[(2 * lane + 1) * 72 + t] = (bfu)(kp >> 16);
            VST[(2 * lane) * 72 + t] = (bfu)(vp & 0xffffu); VST[(2 * lane + 1) * 72 + t] = (bfu)(vp >> 16); }
        if (lane < 16) { const int t = t0 + (lane & 7), dir = lane >> 3; const bfu* gp = GATES + (size_t)(rowbase + t) * 32 + dir * 8 + h;
            const float bl = bf2f(gp[0]), al = bf2f(gp[16]) + a.in[10][dir * 8 + h];
            const float sp = fmaxf(al, 0.f) + log1pf(__expf(-fabsf(al)));
            SM[dir * 64 + t] = 1.f / (1.f + __expf(-bl)); SM[128 + dir * 64 + t] = -__expf(a.in[9][dir * 8 + h]) * sp; }
    }
    __syncthreads();
    if (wave < 2) { const int dir = wave, t = dir ? 63 - lane : lane; float xg = SM[128 + dir * 64 + t];
#pragma unroll
        for (int off = 1; off < 64; off <<= 1) { const float y = __shfl_up(xg, off); if (lane >= off) xg += y; }
        const float gl = __shfl(xg, 63); const float eg = __expf(xg), ek = __expf(gl - xg);
        SM[256 + dir * 64 + t] = xg; SM[384 + dir * 64 + t] = eg;
        float* SC = (float*)(item + 32768 + dir * DIR_BYTES + 24576); SC[t] = eg; SC[64 + t] = ek; if (lane == 0) SC[128] = __expf(gl); }
#pragma unroll
    for (int p = 0; p < 4; ++p) { const int ci = tid + 512 * p, f = ci >> 6, ln = ci & 63, r = ln & 31, hh = ln >> 5; const bfu* src;
        if (f < 16) { const int mt = f >> 3, ks = f & 7; src = QS + (32 * mt + r) * 136 + 16 * ks + 8 * hh; }
        else { const int f2 = f - 16, mt = f2 >> 2, ks = f2 & 3; src = KST + (32 * mt + r) * 72 + 16 * ks + 8 * hh; }
        *(v4u*)(item + (size_t)ci * 16) = *(const v4u*)src; }
    __syncthreads();
    { const int which = wave >> 2, ti = (wave >> 1) & 1, tj = wave & 1; f32x16 c = {};
      if (which == 0) {
#pragma unroll
          for (int ks = 0; ks < 8; ++ks) { const v8s af = *(const v8s*)(KS + (32 * ti + n32) * 136 + 16 * ks + 8 * hi), bf = *(const v8s*)(KS + (32 * tj + n32) * 136 + 16 * ks + 8 * hi); c = MFMA32(af, bf, c); }
          const int j = 32 * tj + n32;
#pragma unroll 1
          for (int dir = 0; dir < 2; ++dir) { const float gj = SM[256 + dir * 64 + j]; const int lj = dir ? 63 - j : j;
#pragma unroll
              for (int r = 0; r < 16; ++r) { const int i = 32 * ti + crow_(r, hi); const bool cond = dir ? (j > i) : (j < i);
                  const float v = cond ? SM[dir * 64 + i] * c[r] * __expf(fminf(SM[256 + dir * 64 + i] - gj, 0.f)) : 0.f; const int li = dir ? 63 - i : i;
                  AMAT[dir * 4096 + li * 64 + lj] = v; } }
      } else {
#pragma unroll
          for (int ks = 0; ks < 8; ++ks) { const v8s af = *(const v8s*)(KS + (32 * tj + n32) * 136 + 16 * ks + 8 * hi), bf = *(const v8s*)(QS + (32 * ti + n32) * 136 + 16 * ks + 8 * hi); c = MFMA32(af, bf, c); }
          const int i = 32 * ti + n32;
#pragma unroll 1
          for (int dir = 0; dir < 2; ++dir) { const float gi = SM[256 + dir * 64 + i]; f32x16 p;
#pragma unroll
              for (int r = 0; r < 16; ++r) { const int j = 32 * tj + crow_(r, hi); const bool cond = dir ? (j >= i) : (j <= i);
                  p[r] = cond ? c[r] * __expf(fminf(gi - SM[256 + dir * 64 + j], 0.f)) : 0.f; }
              unsigned char* dst = item + 32768 + dir * DIR_BYTES + 16384;
              *(v8s*)(dst + ((ti * 4 + 2 * tj + 0) * 64 + lane) * 16) = pk4<0>(p); *(v8s*)(dst + ((ti * 4 + 2 * tj + 1) * 64 + lane) * 16) = pk4<8>(p); }
      } }
    __syncthreads();
    if (wave < 2) { const int dir = wave; const float* Am = AMAT + dir * 4096; float T[64];
#pragma unroll
        for (int i = 0; i < 64; ++i) T[i] = 0.f;
#pragma unroll
        for (int i = 0; i < 64; ++i) { float acc = (i == lane) ? 1.f : 0.f;
#pragma unroll
            for (int j4 = 0; j4 < (i + 3) / 4; ++j4) { const v4f av = *(const v4f*)(Am + i * 64 + 4 * j4);
                acc -= av.x * T[4 * j4]; acc -= av.y * T[4 * j4 + 1]; acc -= av.z * T[4 * j4 + 2]; acc -= av.w * T[4 * j4 + 3]; }
            T[i] = acc; asm volatile("" ::: "memory"); __builtin_amdgcn_sched_barrier(0); }
        const int oc = dir ? 63 - lane : lane; const float bc = SM[dir * 64 + oc], bw = -bc * SM[384 + dir * 64 + oc];
        bfu* TU = TUW + (dir * 2) * 4608; bfu* TW = TU + 4608;
#pragma unroll
        for (int i = 0; i < 64; ++i) { const int oi = dir ? 63 - i : i; const unsigned w = cvtpk2(T[i] * bc, T[i] * bw); TU[oi * 72 + oc] = (bfu)(w & 0xffffu); TW[oi * 72 + oc] = (bfu)(w >> 16); } }
    __syncthreads();
#pragma unroll
    for (int s = 0; s < 4; ++s) { const int q = wave * 4 + s, dir = q >> 4, prod = (q >> 3) & 1, mt = (q >> 2) & 1, nt = q & 3; f32x16 c = {};
        const bfu* TU = TUW + (dir * 2) * 4608; const bfu* TW = TU + 4608; unsigned char* dbase = item + 32768 + dir * DIR_BYTES;
        if (prod == 0) {
#pragma unroll
            for (int ks = 0; ks < 4; ++ks) { const v8s af = *(const v8s*)(TU + (32 * mt + n32) * 72 + 16 * ks + 8 * hi), bf = *(const v8s*)(VST + (32 * nt + n32) * 72 + 16 * ks + 8 * hi); c = MFMA32(af, bf, c); }
            v4u w0, w1; w0.x = cvtpk2(c[0], c[1]); w0.y = cvtpk2(c[2], c[3]); w0.z = cvtpk2(c[4], c[5]); w0.w = cvtpk2(c[6], c[7]);
            w1.x = cvtpk2(c[8], c[9]); w1.y = cvtpk2(c[10], c[11]); w1.z = cvtpk2(c[12], c[13]); w1.w = cvtpk2(c[14], c[15]);
            unsigned char* up = dbase + 25600 + ((nt * 2 + mt) * 64 + lane) * 32; *(v4u*)up = w0; *(v4u*)(up + 16) = w1;
        } else {
#pragma unroll
            for (int ks = 0; ks < 4; ++ks) { const v8s af = *(const v8s*)(KST + (32 * nt + n32) * 72 + 16 * ks + 8 * hi), bf = *(const v8s*)(TW + (32 * mt + n32) * 72 + 16 * ks + 8 * hi); c = MFMA32(af, bf, c); }
            *(v8s*)(dbase + ((mt * 8 + 2 * nt + 0) * 64 + lane) * 16) = pk4<0>(c); *(v8s*)(dbase + ((mt * 8 + 2 * nt + 1) * 64 + lane) * 16) = pk4<8>(c);
        } }
    __syncthreads();
}

__device__ __forceinline__ int cidx_of(int step, int dir) { return dir == 0 ? step : (step < 4 ? 3 - step : 263 - step); }
constexpr int SBUF = 32768 + 25600 + 16384;
__device__ __forceinline__ void scan_step(const char* bufp, bool store, bfu* op, int wsl, f32x16& S0, f32x16& S1, f32x16& S2, f32x16& S3, v8s (&Sb)[8], int lane, int hi) {
    f32x16 vn0, vn1, oq0 = {}, oq1 = {};
    v4u ureg[4]; { const char* up = bufp + 58368 + ((wsl * 2) * 64 + lane) * 32; ureg[0] = *(const v4u*)up; ureg[1] = *(const v4u*)(up + 16); ureg[2] = *(const v4u*)(up + 2048); ureg[3] = *(const v4u*)(up + 2048 + 16); }
#pragma unroll
    for (int i = 0; i < 4; ++i) { vn0[2 * i] = bflo(ureg[0][i]); vn0[2 * i + 1] = bfhi(ureg[0][i]); vn0[8 + 2 * i] = bflo(ureg[1][i]); vn0[8 + 2 * i + 1] = bfhi(ureg[1][i]);
        vn1[2 * i] = bflo(ureg[2][i]); vn1[2 * i + 1] = bfhi(ureg[2][i]); vn1[8 + 2 * i] = bflo(ureg[3][i]); vn1[8 + 2 * i + 1] = bfhi(ureg[3][i]); }
#pragma unroll
    for (int ks = 0; ks < 8; ++ks) {
        const v8s w0 = *(const v8s*)(bufp + 32768 + (ks) * 1024 + lane * 16), w1 = *(const v8s*)(bufp + 32768 + (8 + ks) * 1024 + lane * 16);
        const v8s q0 = *(const v8s*)(bufp + (ks) * 1024 + lane * 16), q1 = *(const v8s*)(bufp + (8 + ks) * 1024 + lane * 16);
        vn0 = MFMA32(w0, Sb[ks], vn0); vn1 = MFMA32(w1, Sb[ks], vn1); oq0 = MFMA32(q0, Sb[ks], oq0); oq1 = MFMA32(q1, Sb[ks], oq1); }
    const float* SC = (const float*)(bufp + 57344);
    f32x16 vs0, vs1;
#pragma unroll
    for (int q = 0; q < 4; ++q) { const v4f e0 = *(const v4f*)(SC + 64 + 8 * q + 4 * hi), e1 = *(const v4f*)(SC + 64 + 32 + 8 * q + 4 * hi);
        const v4f g0 = *(const v4f*)(SC + 8 * q + 4 * hi), g1 = *(const v4f*)(SC + 32 + 8 * q + 4 * hi);
#pragma unroll
        for (int j = 0; j < 4; ++j) { vs0[4 * q + j] = vn0[4 * q + j] * e0[j]; vs1[4 * q + j] = vn1[4 * q + j] * e1[j]; oq0[4 * q + j] *= g0[j]; oq1[4 * q + j] *= g1[j]; } }
    v8s Vb[4], Vs[4];
    Vb[0] = pk4<0>(vn0); Vb[1] = pk4<8>(vn0); Vb[2] = pk4<0>(vn1); Vb[3] = pk4<8>(vn1);
    Vs[0] = pk4<0>(vs0); Vs[1] = pk4<8>(vs0); Vs[2] = pk4<0>(vs1); Vs[3] = pk4<8>(vs1);
#pragma unroll
    for (int ks = 0; ks < 4; ++ks) { const v8s i0 = *(const v8s*)(bufp + 49152 + (ks) * 1024 + lane * 16), i1 = *(const v8s*)(bufp + 49152 + (4 + ks) * 1024 + lane * 16);
        oq0 = MFMA32(i0, Vb[ks], oq0); oq1 = MFMA32(i1, Vb[ks], oq1); }
    if (store) {
#pragma unroll
        for (int r = 0; r < 16; ++r) { const int t = crow_(r, hi); op[(size_t)t * 1024] = (bfu)(cvtpk2(oq0[r], 0.f) & 0xffffu); op[(size_t)(32 + t) * 1024] = (bfu)(cvtpk2(oq1[r], 0.f) & 0xffffu); } }
    const float eL = SC[128];
#define S_UPD(SX, mt4) do { SX = SX * eL; _Pragma("unroll") for (int ks = 0; ks < 4; ++ks) { const v8s kf = *(const v8s*)(bufp + 16384 + ((mt4) * 4 + ks) * 1024 + lane * 16); SX = MFMA32(kf, Vs[ks], SX); } \
        Sb[2 * (mt4)] = pk4<0>(SX); Sb[2 * (mt4) + 1] = pk4<8>(SX); } while (0)
    S_UPD(S0, 0); S_UPD(S1, 1); S_UPD(S2, 2); S_UPD(S3, 3);
#undef S_UPD
}
__device__ __forceinline__ void scan_item(const Args& a, char* lds, int sid) {
    const int tid = threadIdx.x, lane = tid & 63, wave = tid >> 6, hi = lane >> 5, n32 = lane & 31;
    const int b = sid >> 4, h = (sid >> 1) & 7, dir = sid & 1;
    const unsigned char* frag0 = a.ws + WS_FRAG + (size_t)((b * GH + h) * NCH) * ITEM_BYTES;
    bfu* OG = (bfu*)(a.ws + WS_QKVG) + (size_t)dir * NB * SEQ * 1024;
    const bool loader = wave >= 4; const int lt = tid - 256, wsl = wave;
#define LD_ISSUE(ST, step) do { const unsigned char* itp = frag0 + (size_t)cidx_of((step), dir) * ITEM_BYTES; const unsigned char* dp = itp + dir * DIR_BYTES; \
        _Pragma("unroll") for (int p = 0; p < 8; ++p) ST[p] = *(const v4u*)(itp + p * 4096 + lt * 16); \
        _Pragma("unroll") for (int p = 8; p < 18; ++p) ST[p] = *(const v4u*)(dp + p * 4096 + lt * 16); \
        if (lt < 64) ST[18] = *(const v4u*)(dp + 18 * 4096 + lt * 16); } while (0)
#define LD_WRITE(ST, bi) do { char* d = lds + (bi) * SBUF; _Pragma("unroll") for (int p = 0; p < 18; ++p) *(v4u*)(d + p * 4096 + lt * 16) = ST[p]; if (lt < 64) *(v4u*)(d + 18 * 4096 + lt * 16) = ST[18]; } while (0)
#define U_ISSUE(UR, step) do { const unsigned char* up = frag0 + (size_t)cidx_of((step), dir) * ITEM_BYTES + 32768 + dir * DIR_BYTES + 25600 + ((wsl * 2) * 64 + lane) * 32; \
        UR[0] = *(const v4u*)up; UR[1] = *(const v4u*)(up + 16); UR[2] = *(const v4u*)(up + 2048); UR[3] = *(const v4u*)(up + 2048 + 16); } while (0)
#define LBAR() do { asm volatile("s_waitcnt lgkmcnt(0)" ::: "memory"); __builtin_amdgcn_s_barrier(); asm volatile("" ::: "memory"); } while (0)
    if (loader) {
        v4u r0[19], r1[19];
        LD_ISSUE(r0, 0); LD_ISSUE(r1, 1); LD_WRITE(r0, 0); LD_ISSUE(r0, 2);
        for (int step = 0; step < NCH; step += 2) {
            LBAR();
            LD_WRITE(r1, 1); if (step + 3 < NCH) LD_ISSUE(r1, step + 3);
            LBAR();
            if (step + 2 < NCH) { LD_WRITE(r0, 0); if (step + 4 < NCH) LD_ISSUE(r0, step + 4); }
        }
    } else {
        f32x16 S0 = {}, S1 = {}, S2 = {}, S3 = {}; v8s Sb[8];
#pragma unroll
        for (int i = 0; i < 8; ++i) Sb[i] = (v8s){0, 0, 0, 0, 0, 0, 0, 0};
        bfu* obase = OG + (size_t)b * SEQ * 1024 + h * 128 + 32 * wsl + n32;
        for (int step = 0; step < NCH; step += 2) {
            LBAR();
            { const int cidx = cidx_of(step, dir); scan_step(lds, cidx >= 4, obase + (size_t)(cidx - 4) * 64 * 1024, wsl, S0, S1, S2, S3, Sb, lane, hi); }
            LBAR();
            { const int cidx = cidx_of(step + 1, dir); scan_step(lds + SBUF, cidx >= 4, obase + (size_t)(cidx - 4) * 64 * 1024, wsl, S0, S1, S2, S3, Sb, lane, hi); }
        }
    }
    __syncthreads();
#undef LBAR
#undef LD_ISSUE
#undef LD_WRITE
#undef U_ISSUE
}

__device__ __forceinline__ void phase5(const Args& a) {
    const int tid = threadIdx.x, lane = tid & 63, wave = tid >> 6;
    const int gw = blockIdx.x * 8 + wave, NGW = gridDim.x * 8;
    const bfu* OF = (const bfu*)(a.ws + WS_QKVG); const bfu* OB = OF + (size_t)NB * SEQ * 1024; bfu* Z = (bfu*)(a.ws + WS_Z);
    const float gw0 = a.in[11][2 * lane], gw1 = a.in[11][2 * lane + 1];
    for (int lr = gw; lr < NB * SEQ; lr += NGW) { const int b = lr / SEQ; const size_t zrow = (size_t)lr + CTXL * (b + 1);
#pragma unroll
        for (int hh = 0; hh < 8; ++hh) { const int c0 = hh * 128 + 2 * lane;
            const unsigned f = *(const unsigned*)(OF + (size_t)lr * 1024 + c0), g = *(const unsigned*)(OB + (size_t)lr * 1024 + c0);
            unsigned* zp = (unsigned*)(Z + zrow * 2048 + c0); const unsigned zz = *zp;
            const float o0 = bflo(f) + bflo(g), o1 = bfhi(f) + bfhi(g);
            const float r = rsqrtf(wave_sum(o0 * o0 + o1 * o1) * (1.f / 128.f) + EPSF);
            *zp = cvtpk2(o0 * r * gw0 * siluf(bflo(zz)), o1 * r * gw1 * siluf(bfhi(zz))); }
    }
}
__device__ __forceinline__ void phase7(const Args& a) {
    const int tid = threadIdx.x, lane = tid & 63, wave = tid >> 6;
    const int gw = blockIdx.x * 8 + wave, NGW = gridDim.x * 8; const float* fw = a.in[15];
    for (int row = gw; row < NB * SEQ; row += NGW) { v4f* p = (v4f*)(a.out + (size_t)row * DM); v4f v[8]; float ss = 0.f;
#pragma unroll
        for (int j = 0; j < 8; ++j) { v[j] = p[lane + 64 * j]; ss += (v[j].x * v[j].x + v[j].y * v[j].y) + (v[j].z * v[j].z + v[j].w * v[j].w); }
        const float rstd = rsqrtf(wave_sum(ss) * (1.f / DM) + EPSF);
#pragma unroll
        for (int j = 0; j < 8; ++j) { const v4f w = ((const v4f*)fw)[lane + 64 * j]; p[lane + 64 * j] = (v[j] * rstd) * w; }
    }
}

__global__ void __launch_bounds__(512, 2) mega_fwd(Args a) {
    extern __shared__ __attribute__((aligned(16))) unsigned char lds_[];
    char* lds = (char*)lds_;
    cg::grid_group grid = cg::this_grid();
    const int lo = a.ph_lo, hi = a.ph_hi;
    unsigned char* ws = a.ws;
#ifndef MK_SKIP
#define MK_SKIP 0
#endif
#define IN(k) (!((MK_SKIP >> (k)) & 1) && lo <= (k) && (k) < hi)
#define SEAM(k) do { if (IN(k) && IN((k) + 1)) grid.sync(); } while (0)
#ifndef MK_DUP
#define MK_DUP 0
#endif
#define DUP(k) ((MK_DUP >> (k)) & 1)
    if (IN(0)) { phase0(a, lds); if (DUP(0)) { __syncthreads(); phase0(a, lds); } } SEAM(0);
    if (IN(1)) { phase1(a); if (DUP(1)) phase1(a); } SEAM(1);
    for (int rep = 0; rep < 1 + DUP(2); ++rep) if (IN(2)) {
        pg8::Gemm g{(const pg8::bf16_t*)((const unsigned char*)a.out + OUT_H), (const pg8::bf16_t*)((const unsigned char*)a.out + OUT_WIN), MROWS, NPAD, DM}; InOrder S; S.so.init(MROWS, 13 * 256, (int)gridDim.x, (int)blockIdx.x); S.limit = 130 * 13; S.mode = 0;
        EpiIn E{(bfu*)(ws + WS_QKVG), (bfu*)(ws + WS_Z), (bfu*)(ws + WS_QKVA), (bfu*)(ws + WS_GATES)};
        pg8::gemm_phase<EpiIn, InOrder, true, true>((PG8_LAS unsigned char*)lds_, g, S, E);
    } SEAM(2);
    if (IN(3)) {
        for (int rep = 0; rep < 1 + DUP(3); ++rep) for (int it = blockIdx.x; it < NB * GH * NCH; it += gridDim.x) prep_item(a, lds, it);
    } SEAM(3);
    if (IN(4)) {
        constexpr int NSCAN = 32, NUB = 130 * 14;
        const bool scanner = (int)blockIdx.x < NSCAN;
        if (scanner) { scan_item(a, lds, (int)blockIdx.x); if (DUP(4)) scan_item(a, lds, (int)blockIdx.x); }
        pg8::Gemm g{(const pg8::bf16_t*)((const unsigned char*)a.out + OUT_H), (const pg8::bf16_t*)((const unsigned char*)a.out + OUT_WIN), MROWS, NPAD, DM}; InOrder S; S.mode = 1;
        if (scanner) { S.so.init(MROWS, 14 * 256, 1 << 20, NUB - NSCAN + (int)blockIdx.x); S.limit = NUB; }
        else { S.so.init(MROWS, 14 * 256, (int)gridDim.x - NSCAN, (int)blockIdx.x - NSCAN); S.limit = NUB - NSCAN; }
        EpiIn E{(bfu*)(ws + WS_QKVG), (bfu*)(ws + WS_Z), (bfu*)(ws + WS_QKVA), (bfu*)(ws + WS_GATES)};
        pg8::gemm_phase<EpiIn, InOrder, true, true>((PG8_LAS unsigned char*)lds_, g, S, E);
    } SEAM(4);
    if (IN(5)) { phase3a(a); phase5(a); } SEAM(5);
    if (IN(6)) {
        for (int u = blockIdx.x; u < 1024; u += gridDim.x) {
            __syncthreads();
            const int bkv = u >> 8, b = bkv >> 1, kvh = bkv & 1, rem = u & 255, g4 = rem >> 6, qb = rem & 63, head = kvh * 4 + g4;
            const bfu* QKVA = (const bfu*)(ws + WS_QKVA);
            const bfu* Qp = QKVA + (size_t)(b * TOK + CTXL + qb * 256) * 1536 + head * 128;
            const bfu* Kp = (const bfu*)(ws + WS_KC) + (size_t)(b * 2 + kvh) * TOK * 128; const bfu* Vp = (const bfu*)(ws + WS_VC) + (size_t)(b * 2 + kvh) * TOK * 128;
            bfu* Zp = (bfu*)(ws + WS_Z) + (size_t)(b * TOK + CTXL + qb * 256) * 2048 + 1024 + head * 128;
            att::attn_dense_body<att::bf16>((const att::bf16*)Qp, (const att::bf16*)Kp, (const att::bf16*)Vp, Zp, TOK, lds);
        }
    } SEAM(6);
    for (int rep = 0; rep < 1 + DUP(7); ++rep) if (IN(7)) {
        pg8::Gemm g{(const pg8::bf16_t*)(ws + WS_Z), (const pg8::bf16_t*)(ws + WS_WOUT), NB * SEQ, DM, DM}; OutOrder S; S.so.init(NB * SEQ, DM, (int)gridDim.x, (int)blockIdx.x);
        EpiOut E{a.in[0], (const float*)(ws + WS_MOD), a.out};
        pg8::gemm_phase<EpiOut, OutOrder, true, true>((PG8_LAS unsigned char*)lds_, g, S, E);
    } SEAM(7);
    if (IN(8)) { phase7(a); }
#undef IN
#undef SEAM
}

extern "C" void kernel_launch(void* const* d_in, const int* in_sizes, int n_in, void* d_out, int out_size, void* d_ws, size_t ws_size, hipStream_t stream) {
    static int grid = 0;
    if (grid == 0) {
        if (n_in != 16 || out_size != NB * SEQ * DM || ws_size < WS_END) { fprintf(stderr, "kernel_launch: unexpected shapes (n_in %d out %d ws %zu need %zu)\n", n_in, out_size, ws_size, (size_t)WS_END); grid = -1; return; }
        int dev = 0, cus = 0, per_cu = 0;
        hipGetDevice(&dev); hipDeviceGetAttribute(&cus, hipDeviceAttributeMultiprocessorCount, dev);
        if (hipFuncSetAttribute((const void*)mega_fwd, hipFuncAttributeMaxDynamicSharedMemorySize, LDS_BYTES) != hipSuccess) { fprintf(stderr, "kernel_launch: hipFuncSetAttribute failed\n"); grid = -1; return; }
        if (hipOccupancyMaxActiveBlocksPerMultiprocessor(&per_cu, (const void*)mega_fwd, 512, LDS_BYTES) != hipSuccess || per_cu < 1) { fprintf(stderr, "kernel_launch: occupancy query says %d\n", per_cu); per_cu = 1; }
        (void)hipGetLastError();
        grid = cus * per_cu;
        fprintf(stderr, "kernel_launch: grid %d (cus %d x %d)\n", grid, cus, per_cu);
    }
    if (grid < 0) return;
    Args a{};
    for (int i = 0; i < 16; ++i) a.in[i] = (const float*)d_in[i];
    a.out = (float*)d_out; a.ws = (unsigned char*)d_ws;
#if MK_COOP
    a.ph_lo = 0; a.ph_hi = NPHASE;
    void* args[] = {&a};
    hipError_t e = hipLaunchCooperativeKernel((const void*)mega_fwd, dim3(grid), dim3(512), args, LDS_BYTES, stream);
    if (e != hipSuccess) fprintf(stderr, "kernel_launch: cooperative launch failed: %s (grid %d)\n", hipGetErrorString(e), grid);
#else
    for (int p = 0; p < NPHASE; ++p) { a.ph_lo = p; a.ph_hi = p + 1; hipLaunchKernelGGL(mega_fwd, dim3(grid), dim3(512), LDS_BYTES, stream, a); }
#endif
}
```

```cpp
#include <hip/hip_runtime.h>
#include <hip/hip_bf16.h>
#include <hip/hip_cooperative_groups.h>
#include <cstdio>
#include <cstdint>
namespace cg = cooperative_groups;

#ifndef ATT_PROBE_K
#define ATT_PROBE_K 1.f
#endif
#ifndef MK_COOP
#define MK_COOP 1
#endif

constexpr int DM = 2048, NB = 2, SEQ = 16384, CTXL = 256, TOK = SEQ + CTXL, MROWS = NB * TOK;
constexpr int HD = 128, GH = 8, NCH = TOK / 64;
constexpr int INC = 6688, NPAD = 6912;
constexpr float EPSF = 1e-6f;
constexpr int NPHASE = 9;

constexpr size_t WS_CNT = 0, WS_MOD = 4096, WS_WOUT = 131072;
constexpr size_t WS_GATES = WS_WOUT + (size_t)DM * DM * 2;
constexpr size_t WS_Z = WS_GATES + (size_t)MROWS * 32 * 2;
constexpr size_t WS_QKVA = WS_Z + (size_t)MROWS * 2048 * 2;
constexpr size_t WS_QKVG = WS_QKVA + (size_t)MROWS * 1536 * 2;
constexpr size_t WS_FRAG = WS_QKVG + (size_t)MROWS * 3072 * 2;
constexpr size_t DIR_BYTES = 16384 + 8192 + 1024 + 16384;
constexpr size_t ITEM_BYTES = 32768 + 2 * DIR_BYTES;
constexpr size_t WS_KC = WS_FRAG + (size_t)NB * GH * NCH * ITEM_BYTES;
constexpr size_t WS_VC = WS_KC + (size_t)NB * 2 * TOK * 128 * 2;
constexpr size_t WS_BAR = WS_VC + (size_t)NB * 2 * TOK * 128 * 2;
constexpr size_t WS_XBUF = WS_BAR + 16384;
constexpr size_t WS_PCNT = WS_XBUF + (size_t)NB * SEQ * 8 * 4;
constexpr size_t WS_END = WS_PCNT + 128 * 256;
constexpr size_t OUT_H = 0, OUT_WIN = (size_t)MROWS * DM * 2;
static_assert(OUT_WIN + (size_t)NPAD * DM * 2 <= (size_t)NB * SEQ * DM * 4, "H + WinT fit in d_out");
static_assert((size_t)2 * NB * SEQ * 1024 * 2 <= (size_t)MROWS * 3072 * 2, "O_gdn fits over QKVG");

constexpr int LDS_BYTES = 151552;

typedef unsigned short bfu;
typedef float f32x16 __attribute__((ext_vector_type(16)));
typedef unsigned u32x2 __attribute__((ext_vector_type(2)));
__device__ __forceinline__ float bf2f(unsigned short u) { return __uint_as_float(((unsigned)u) << 16); }
__device__ __forceinline__ float bflo(unsigned w) { return __uint_as_float(w << 16); }
__device__ __forceinline__ float bfhi(unsigned w) { return __uint_as_float(w & 0xffff0000u); }
__device__ __forceinline__ float wave_sum(float v) {
#pragma unroll
    for (int o = 1; o < 64; o <<= 1) v += __shfl_xor(v, o);
    return v;
}
__device__ __forceinline__ float siluf(float x) { return x * __builtin_amdgcn_rcpf(1.f + __expf(-x)); }

namespace pg8 {
#define PG8_LAS __attribute__((address_space(3)))
typedef unsigned short bf16_t;
typedef short bf16x8 __attribute__((ext_vector_type(8)));
typedef float f32x4 __attribute__((ext_vector_type(4)));
typedef unsigned u32x4 __attribute__((ext_vector_type(4)));
constexpr int BM = 256, BK = 64, HALF = 128, HTB = HALF * BK * 2  , STAGE_BYTES = 8 * HTB, NXCD = 8, WGM = 8;

__host__ __device__ __forceinline__ int lds_byte(int r, int c) { const int st = (r >> 4) * 2 + (c >> 5), rr = r & 15, cc = c & 31, ob = rr * 64 + cc * 2; return st * 1024 + (ob ^ (((ob >> 9) & 1) << 5)); }
__host__ __device__ __forceinline__ void stage_rc(int b, int& R, int& C) { const int st = b / 1024, sb = b % 1024, swz = sb ^ (((sb >> 9) & 1) << 5); R = (st >> 1) * 16 + swz / 64; C = (st & 1) * 32 + (swz % 64) / 2; }
__host__ __device__ __forceinline__ int perm32(int rho) { const int n = rho >> 4, i = rho & 15; return 8 * (i >> 2) + 4 * n + (i & 3); }

struct Unit { int pm, pn; };
struct Gemm { const bf16_t* A; const bf16_t* Bt; int M, N, K; };

struct StaticOrder {
    int nM, nN, nwg, G, c;
    __host__ __device__ void init(int M, int N, int G_, int c_) { nM = M / BM; nN = N / BM; nwg = nM * nN; G = G_; c = c_; }
    __host__ __device__ bool next(int i, Unit& u) const {
        const long L = (long)i * G + c; if (L >= nwg) return false;
        int wgid = (int)L; { const int q = nwg / NXCD, r = nwg % NXCD, xcd = wgid % NXCD, off = wgid / NXCD; wgid = (xcd < r ? xcd * (q + 1) : r * (q + 1) + (xcd - r) * q) + off; }
        const int nig = WGM * nN, gid = wgid / nig, fm = gid * WGM, gsz = (nM - fm) < WGM ? (nM - fm) : WGM;
        u.pm = fm + ((wgid % nig) % gsz); u.pn = (wgid % nig) / gsz; return true;
    }
    __device__ __forceinline__ void a_ready(const Unit&) const {}
    __device__ __forceinline__ void done(const Unit&) const {}
};

__device__ __forceinline__ unsigned cvt_pk_bf16(float lo, float hi) { unsigned r; asm volatile("v_cvt_pk_bf16_f32 %0, %1, %2" : "=v"(r) : "v"(lo), "v"(hi)); return r; }
template <class Epi, class Sched, bool ALIGN_EPI = false, bool SP2 = false>
__device__ __forceinline__ void gemm_phase(PG8_LAS unsigned char* lds, const Gemm g, const Sched& S, const Epi& E) {
    const int tid = threadIdx.x, wid = __builtin_amdgcn_readfirstlane(tid >> 6), lane = tid & 63, wr = wid >> 2, wc = wid & 3, fr = lane & 15, fq = lane >> 4;
    const int K = g.K, nt = K / BK;
    unsigned voffA[2], voffB[2];
#pragma unroll
    for (int i = 0; i < 2; ++i) { int R, C; stage_rc(tid * 16 + i * 8192, R, C); const int Rb = Epi::PERM ? ((R & ~31) + perm32(R & 31)) : R;
        voffA[i] = (unsigned)(R * K + C) * 2u; voffB[i] = (unsigned)(Rb * K + C) * 2u; }
    const size_t kstep = (size_t)(BK * 2);
    const size_t hstep = (size_t)HALF * K * 2;
    const size_t tstep = 2 * hstep;
    const unsigned ldsw = (unsigned)wid * 1024u;
    const int aoff = lds_byte(wr * 64 + fr, fq * 8), boff = lds_byte(wc * 32 + fr, fq * 8);
#define PG8_SA(b, h) (((b) * 2 + (h)) * HTB)
#define PG8_SB(b, h) ((4 + (b) * 2 + (h)) * HTB)
#define PG8_STAGE(bufoff, gbase, voff) do { _Pragma("unroll") for (int _i = 0; _i < 2; ++_i) \
        __builtin_amdgcn_global_load_lds((const unsigned*)((const char*)(gbase) + (voff)[_i]), (PG8_LAS unsigned*)(lds + (bufoff) + ldsw + _i * 8192), 16, 0, 0); } while (0)
#define PG8_LDA(dst, b, h) do { _Pragma("unroll") for (int m = 0; m < 4; ++m) _Pragma("unroll") for (int k = 0; k < 2; ++k) dst[m][k] = *(const PG8_LAS bf16x8*)(lds + PG8_SA(b, h) + aoff + m * 2048 + k * 1024); } while (0)
#define PG8_LDB(dst, b, h) do { _Pragma("unroll") for (int n = 0; n < 2; ++n) _Pragma("unroll") for (int k = 0; k < 2; ++k) dst[n][k] = *(const PG8_LAS bf16x8*)(lds + PG8_SB(b, h) + boff + n * 2048 + k * 1024); } while (0)
#define PG8_MMA(ai, bj, At, Bt) do { __builtin_amdgcn_s_setprio(1); _Pragma("unroll") for (int m = 0; m < 4; ++m) _Pragma("unroll") for (int n = 0; n < 2; ++n) _Pragma("unroll") for (int k = 0; k < 2; ++k) \
        acc[ai][bj][m][n] = __builtin_amdgcn_mfma_f32_16x16x32_bf16(Bt[n][k], At[m][k], acc[ai][bj][m][n], 0, 0, 0); __builtin_amdgcn_s_setprio(0); } while (0)
#define PG8_WAIT_V(n) asm volatile("s_waitcnt vmcnt(" #n ")" ::: "memory")
#define PG8_WAIT_L(n) asm volatile("s_waitcnt lgkmcnt(" #n ")" ::: "memory")
#define PG8_BAR __builtin_amdgcn_s_barrier()
#define PG8_SCHED __builtin_amdgcn_sched_barrier(0)
    Unit cur, nxt; int ui = 0;
    if (!S.next(0, cur)) return;
    f32x4 acc[2][2][4][2];
#pragma unroll
    for (int a = 0; a < 2; ++a)
#pragma unroll
        for (int b = 0; b < 2; ++b)
#pragma unroll
            for (int m = 0; m < 4; ++m)
#pragma unroll
                for (int n = 0; n < 2; ++n) acc[a][b][m][n] = (f32x4){0.f, 0.f, 0.f, 0.f};
    bf16x8 At[4][2], B0[2][2], B1[2][2];
    const char* cA = (const char*)g.A + (size_t)cur.pm * tstep; const char* cB = (const char*)g.Bt + (size_t)cur.pn * tstep;
    S.a_ready(cur);
    if constexpr (SP2) {
        PG8_STAGE(PG8_SB(0, 0), cB, voffB); PG8_STAGE(PG8_SB(0, 1), cB + hstep, voffB); PG8_STAGE(PG8_SA(0, 0), cA, voffA); PG8_STAGE(PG8_SA(0, 1), cA + hstep, voffA);
        if (wr == 1) PG8_BAR;
        PG8_WAIT_V(2); PG8_BAR;
        PG8_STAGE(PG8_SB(1, 0), cB + kstep, voffB); PG8_STAGE(PG8_SA(1, 0), cA + kstep, voffA); PG8_STAGE(PG8_SB(1, 1), cB + hstep + kstep, voffB);
        PG8_WAIT_V(6); PG8_BAR;
    } else {
        PG8_STAGE(PG8_SB(0, 0), cB, voffB); PG8_STAGE(PG8_SA(0, 0), cA, voffA); PG8_STAGE(PG8_SB(0, 1), cB + hstep, voffB); PG8_STAGE(PG8_SA(0, 1), cA + hstep, voffA);
        if (wr == 1) PG8_BAR;
        PG8_WAIT_V(4); PG8_BAR;
        PG8_STAGE(PG8_SB(1, 0), cB + kstep, voffB); PG8_STAGE(PG8_SA(1, 0), cA + kstep, voffA); PG8_STAGE(PG8_SB(1, 1), cB + hstep + kstep, voffB);
        PG8_WAIT_V(6); PG8_BAR;
    }
    for (;;) {
        const bool has_next = S.next(ui + 1, nxt);
        const char* nA = has_next ? (const char*)g.A + (size_t)nxt.pm * tstep : cA; const char* nB = has_next ? (const char*)g.Bt + (size_t)nxt.pn * tstep : cB;
        for (int t = 0; t < nt; t += 2) {
            const bool last = (t == nt - 2);
            const char* a1 = cA + (size_t)(t + 1) * kstep;
            const char* a2 = last ? nA : cA + (size_t)(t + 2) * kstep; const char* b2 = last ? nB : cB + (size_t)(t + 2) * kstep;
            const char* a3 = a2 + kstep; const char* b3 = b2 + kstep;
            if (last && has_next) S.a_ready(nxt);
            if constexpr (SP2) {
            PG8_LDB(B0, 0, 0); PG8_LDB(B1, 0, 1); PG8_SCHED; PG8_LDA(At, 0, 0); PG8_STAGE(PG8_SA(1, 1), a1 + hstep, voffA);
            PG8_WAIT_V(8); PG8_WAIT_L(0); PG8_BAR; PG8_MMA(0, 0, At, B0); PG8_MMA(0, 1, At, B1); PG8_BAR; PG8_SCHED;
            PG8_LDA(At, 0, 1); PG8_STAGE(PG8_SB(0, 0), b2, voffB); PG8_STAGE(PG8_SB(0, 1), b2 + hstep, voffB); PG8_STAGE(PG8_SA(0, 0), a2, voffA);
            PG8_WAIT_V(8); PG8_WAIT_L(0); PG8_BAR; PG8_MMA(1, 0, At, B0); PG8_MMA(1, 1, At, B1); PG8_BAR; PG8_SCHED;
            PG8_LDB(B0, 1, 0); PG8_LDB(B1, 1, 1); PG8_SCHED; PG8_LDA(At, 1, 0); PG8_STAGE(PG8_SA(0, 1), a2 + hstep, voffA);
            PG8_WAIT_V(8); PG8_WAIT_L(0); PG8_BAR; PG8_MMA(0, 0, At, B0); PG8_MMA(0, 1, At, B1); PG8_BAR; PG8_SCHED;
            PG8_LDA(At, 1, 1); PG8_STAGE(PG8_SB(1, 0), b3, voffB); PG8_STAGE(PG8_SB(1, 1), b3 + hstep, voffB); PG8_STAGE(PG8_SA(1, 0), a3, voffA);
            PG8_WAIT_V(8); PG8_WAIT_L(0); PG8_BAR; PG8_MMA(1, 0, At, B0); PG8_MMA(1, 1, At, B1); PG8_BAR; PG8_SCHED;
            } else {
            PG8_LDB(B0, 0, 0); PG8_SCHED; PG8_LDA(At, 0, 0); PG8_STAGE(PG8_SA(1, 1), a1 + hstep, voffA);
            PG8_WAIT_L(8); PG8_BAR; PG8_WAIT_L(0); PG8_MMA(0, 0, At, B0); PG8_BAR; PG8_SCHED;
            PG8_LDB(B1, 0, 1); PG8_STAGE(PG8_SB(0, 0), b2, voffB);
            PG8_BAR; PG8_WAIT_L(0); PG8_MMA(0, 1, At, B1); PG8_BAR;
            PG8_LDA(At, 0, 1); PG8_STAGE(PG8_SA(0, 0), a2, voffA);
            PG8_BAR; PG8_WAIT_L(0); PG8_MMA(1, 0, At, B0); PG8_BAR; PG8_SCHED;
            PG8_STAGE(PG8_SB(0, 1), b2 + hstep, voffB);
            PG8_WAIT_V(6); PG8_BAR; PG8_MMA(1, 1, At, B1); PG8_BAR;
            PG8_LDB(B0, 1, 0); PG8_SCHED; PG8_LDA(At, 1, 0); PG8_STAGE(PG8_SA(0, 1), a2 + hstep, voffA);
            PG8_WAIT_L(8); PG8_BAR; PG8_WAIT_L(0); PG8_MMA(0, 0, At, B0); PG8_BAR; PG8_SCHED;
            PG8_LDB(B1, 1, 1); PG8_STAGE(PG8_SB(1, 0), b3, voffB);
            PG8_BAR; PG8_WAIT_L(0); PG8_MMA(0, 1, At, B1); PG8_BAR;
            PG8_LDA(At, 1, 1); PG8_STAGE(PG8_SA(1, 0), a3, voffA);
            PG8_BAR; PG8_WAIT_L(0); PG8_MMA(1, 0, At, B0); PG8_BAR; PG8_SCHED;
            PG8_STAGE(PG8_SB(1, 1), b3 + hstep, voffB);
            PG8_WAIT_V(6); PG8_BAR; PG8_MMA(1, 1, At, B1); PG8_BAR;
            }
        }
        if constexpr (ALIGN_EPI) { if (wr == 0) PG8_BAR; }
        if constexpr (!Epi::AFTER_DRAIN) { E(acc, cur, wr, wc, fr, fq); S.done(cur); }
        if (!has_next) break;
#pragma unroll
        for (int a = 0; a < 2; ++a)
#pragma unroll
            for (int b = 0; b < 2; ++b)
#pragma unroll
                for (int m = 0; m < 4; ++m)
#pragma unroll
                    for (int n = 0; n < 2; ++n) acc[a][b][m][n] = (f32x4){0.f, 0.f, 0.f, 0.f};
        cur = nxt; cA = nA; cB = nB; ++ui;
        if constexpr (ALIGN_EPI) { if (wr == 1) PG8_BAR; }
    }
    PG8_WAIT_V(0);
    if constexpr (!ALIGN_EPI) { if (wr == 0) PG8_BAR; }
    PG8_BAR;
    if constexpr (Epi::AFTER_DRAIN) { E.fused(acc, cur, wr, wc, fr, fq, lds, wid, lane); S.done(cur); }
#undef PG8_SA
#undef PG8_SB
#undef PG8_STAGE
#undef PG8_LDA
#undef PG8_LDB
#undef PG8_MMA
#undef PG8_WAIT_V
#undef PG8_WAIT_L
#undef PG8_BAR
#undef PG8_SCHED
}
}

namespace att {
using bf16 = __hip_bfloat16;
constexpr int D = 128, NW = 8, QBLK = 32, KVBLK = 64;
constexpr float SCALE = 0.088388347648318440f;
constexpr float THR = 8.f;
constexpr int SDEPTH = 2;
constexpr int LDQ = 1536, LDK = 128, LDO = 2048;
constexpr size_t SHM_V = KVBLK * D * 2, SHM_K = KVBLK * D * 2, SHM_ATTN = 2 * SHM_V + 2 * SHM_K + NW * 64 * 4;
using bf16x8 = __attribute__((ext_vector_type(8))) short;
using s16x4  = __attribute__((ext_vector_type(4))) short;
using f32x16 = __attribute__((ext_vector_type(16))) float;
using f32x8  = __attribute__((ext_vector_type(8))) float;
using u32x4  = __attribute__((ext_vector_type(4))) unsigned;
#define KSWZ(row, colB) ((row) * 256 + ((colB) ^ (((row) & 7) << 4)))
#define SBAR() __builtin_amdgcn_sched_barrier(0)
__device__ __forceinline__ int crow(int r, int hi) { return (r & 3) + 8 * (r >> 2) + 4 * hi; }
__device__ __forceinline__ unsigned cvtpk(float lo, float hi) {
  unsigned r; asm volatile("v_cvt_pk_bf16_f32 %0, %1, %2" : "=v"(r) : "v"(lo), "v"(hi)); return r;
}
template <typename TIn> struct Stage;
template <> struct Stage<bf16>  { using T = bf16x8;
  __device__ static __forceinline__ T ld8(const bf16* p) { return *reinterpret_cast<const bf16x8*>(p); }
  __device__ static __forceinline__ bf16x8 tobf(T x) { return x; } };
template <> struct Stage<float> { using T = f32x8;
  __device__ static __forceinline__ T ld8(const float* p) { return *reinterpret_cast<const f32x8*>(p); }
  __device__ static __forceinline__ bf16x8 tobf(T x) {
    u32x4 w = {cvtpk(x[0], x[1]), cvtpk(x[2], x[3]), cvtpk(x[4], x[5]), cvtpk(x[6], x[7])}; return *reinterpret_cast<bf16x8*>(&w); } };

__device__ __forceinline__ void partialSM(f32x16& p0, f32x16& p1, float& m_reg, float& mn, float& alpha) {
  constexpr float C = SCALE * 1.4426950408889634f;
  float pmax = p0[0]; for (int r = 1; r < 16; ++r) pmax = fmaxf(pmax, p0[r]); for (int r = 0; r < 16; ++r) pmax = fmaxf(pmax, p1[r]);
  { auto rr = __builtin_amdgcn_permlane32_swap(__float_as_uint(pmax), __float_as_uint(pmax), false, false);
    pmax = fmaxf(__uint_as_float(rr[0]), __uint_as_float(rr[1])); }
  if (__builtin_expect(__all(pmax - m_reg <= THR / SCALE), 1)) { mn = m_reg; alpha = 1.f; }
  else { mn = fmaxf(m_reg, pmax); alpha = __builtin_amdgcn_exp2f((m_reg - mn) * C); m_reg = mn; }
  float mnC = -mn * C;
  for (int r = 0; r < 16; ++r) p0[r] = fmaf(p0[r], C, mnC); for (int r = 0; r < 16; ++r) p1[r] = fmaf(p1[r], C, mnC);
  for (int r = 0; r < 16; ++r) p0[r] = __builtin_amdgcn_exp2f(p0[r]);
}
__device__ __forceinline__ void finishSM(f32x16& p0, f32x16& p1, float alpha, float& l_reg, bf16x8& pa0, bf16x8& pa1, bf16x8& pa2, bf16x8& pa3) {
  for (int r = 0; r < 16; ++r) p1[r] = __builtin_amdgcn_exp2f(p1[r]);
  float ps = 0; for (int r = 0; r < 16; ++r) ps += p0[r]; for (int r = 0; r < 16; ++r) ps += p1[r];
  { auto rr = __builtin_amdgcn_permlane32_swap(__float_as_uint(ps), __float_as_uint(ps), false, false);
    ps = __uint_as_float(rr[0]) + __uint_as_float(rr[1]); }
  l_reg = l_reg * alpha + ps;
#define PK4(P, BASE, OUT) do { unsigned a0 = cvtpk(P[BASE + 0], P[BASE + 1]), a1 = cvtpk(P[BASE + 2], P[BASE + 3]);   \
    unsigned b0 = cvtpk(P[BASE + 4], P[BASE + 5]), b1 = cvtpk(P[BASE + 6], P[BASE + 7]);                              \
    auto r0 = __builtin_amdgcn_permlane32_swap(a0, b0, false, false); auto r1 = __builtin_amdgcn_permlane32_swap(a1, b1, false, false); \
    u32x4 w = {r0[0], r1[0], r0[1], r1[1]}; OUT = *reinterpret_cast<bf16x8*>(&w); } while (0)
  PK4(p0, 0, pa0); PK4(p0, 8, pa1); PK4(p1, 0, pa2); PK4(p1, 8, pa3);
#undef PK4
}
__device__ __forceinline__ void qkt(f32x16& p0, f32x16& p1, const bf16* Ks, const bf16x8* qr, int r32, int hi) {
  p0 = f32x16{}; p1 = f32x16{};
  for (int d0 = 0; d0 < 8; ++d0) { int cb = (d0 * 16 + hi * 8) * 2;
    bf16x8 b0 = *reinterpret_cast<const bf16x8*>((const char*)Ks + KSWZ(r32, cb));
    bf16x8 b1 = *reinterpret_cast<const bf16x8*>((const char*)Ks + KSWZ(32 + r32, cb));
    p0 = __builtin_amdgcn_mfma_f32_32x32x16_bf16(b0, qr[d0], p0, 0, 0, 0);
    p1 = __builtin_amdgcn_mfma_f32_32x32x16_bf16(b1, qr[d0], p1, 0, 0, 0); }
}
__device__ __forceinline__ int v_st(int k, int c) { const int kk = (k & ~0xC) | ((k & 4) << 1) | ((k & 8) >> 1); return ((kk >> 3) * 4 + (c >> 5)) * 512 + ((kk & 7) * 32 + (c & 31)) * 2; }
__device__ __forceinline__ int v_rd_base(int lane) { return ((lane & 3) << 3) | (((lane >> 2) & 3) << 6) | (((lane >> 4) & 1) << 5) | (((lane >> 5) & 1) << 8); }
constexpr int v_rd_off(int d0, int ks, int half) { return d0 * 512 + ks * 4096 + half * 2048; }
template <int OFF> __device__ __forceinline__ s16x4 tr_read(int vb) {
  s16x4 r; asm volatile("ds_read_b64_tr_b16 %0, %1 offset:%2" : "=&v"(r) : "v"(vb), "i"(OFF) : "memory"); return r;
}
template <int D0> __device__ __forceinline__ void pv_one(f32x16& od, int vb, bf16x8 pa0, bf16x8 pa1, bf16x8 pa2, bf16x8 pa3) {
  const s16x4 l0 = tr_read<v_rd_off(D0, 0, 0)>(vb), h0 = tr_read<v_rd_off(D0, 0, 1)>(vb), l1 = tr_read<v_rd_off(D0, 1, 0)>(vb), h1 = tr_read<v_rd_off(D0, 1, 1)>(vb);
  const s16x4 l2 = tr_read<v_rd_off(D0, 2, 0)>(vb), h2 = tr_read<v_rd_off(D0, 2, 1)>(vb), l3 = tr_read<v_rd_off(D0, 3, 0)>(vb), h3 = tr_read<v_rd_off(D0, 3, 1)>(vb);
  asm volatile("s_waitcnt lgkmcnt(0)" ::: "memory"); SBAR();
#define PK(L, H) (bf16x8){L[0], L[1], L[2], L[3], H[0], H[1], H[2], H[3]}
  od = __builtin_amdgcn_mfma_f32_32x32x16_bf16(pa0, PK(l0, h0), od, 0, 0, 0);
  od = __builtin_amdgcn_mfma_f32_32x32x16_bf16(pa1, PK(l1, h1), od, 0, 0, 0);
  od = __builtin_amdgcn_mfma_f32_32x32x16_bf16(pa2, PK(l2, h2), od, 0, 0, 0);
  od = __builtin_amdgcn_mfma_f32_32x32x16_bf16(pa3, PK(l3, h3), od, 0, 0, 0);
#undef PK
}
__device__ __forceinline__ void pv_d0(f32x16* o, int vb, bf16x8 pa0, bf16x8 pa1, bf16x8 pa2, bf16x8 pa3) {
  pv_one<0>(o[0], vb, pa0, pa1, pa2, pa3); pv_one<1>(o[1], vb, pa0, pa1, pa2, pa3); pv_one<2>(o[2], vb, pa0, pa1, pa2, pa3); pv_one<3>(o[3], vb, pa0, pa1, pa2, pa3);
}

template <typename TQ>
__device__ __forceinline__ void attn_dense_body(const TQ* __restrict__ Qb, const bf16* __restrict__ Kh, const bf16* __restrict__ Vh,
                                                unsigned short* Ob, int seq, char* lds) {
  using St = Stage<bf16>; using SQ = Stage<TQ>;
  int tid_o = threadIdx.x; asm volatile("" : "+v"(tid_o));
  const int tid = tid_o, wid = tid >> 6, lane = tid & 63, r32 = lane & 31, hi = lane >> 5;
  bf16* V_lds = (bf16*)lds; bf16* K_lds = (bf16*)(lds + 2 * SHM_V);
  float* ws = (float*)(lds + 2 * SHM_V + 2 * SHM_K) + wid * 64; float* li_l = ws; float* al_l = ws + 32;
  float m_reg = -1e30f, l_reg = 0; f32x16 o[4] = {}; bf16x8 qr[8];
  const TQ* Qw = Qb + (long)(wid * QBLK + r32) * LDQ + hi * 8;
#pragma unroll
  for (int d0 = 0; d0 < 8; ++d0) qr[d0] = SQ::tobf(SQ::ld8(Qw + d0 * 16));
  const int sr = tid >> 4, sc = (tid & 15) * 8, vst0 = v_st(sr, sc), vst1 = v_st(32 + sr, sc);
  const int vb0 = (int)(uintptr_t)V_lds + v_rd_base(lane);
  struct { typename St::T vs0, vs1, ks0, ks1; } sr_[SDEPTH];
#define SLOAD(i, k0) do { sr_[i].vs0 = St::ld8(&Vh[(long)((k0) + sr) * LDK + sc]); sr_[i].vs1 = St::ld8(&Vh[(long)((k0) + 32 + sr) * LDK + sc]); \
    sr_[i].ks0 = St::ld8(&Kh[(long)((k0) + sr) * LDK + sc]); sr_[i].ks1 = St::ld8(&Kh[(long)((k0) + 32 + sr) * LDK + sc]); } while (0)
#define SWRITE(b, i) do { *(bf16x8*)((char*)V_lds + (b) * SHM_V + vst0) = St::tobf(sr_[i].vs0);          \
    *(bf16x8*)((char*)V_lds + (b) * SHM_V + vst1) = St::tobf(sr_[i].vs1); int kc = sc * 2;               \
    *(bf16x8*)((char*)K_lds + (b) * SHM_K + KSWZ(sr, kc)) = St::tobf(sr_[i].ks0);                       \
    *(bf16x8*)((char*)K_lds + (b) * SHM_K + KSWZ(32 + sr, kc)) = St::tobf(sr_[i].ks1); } while (0)
#define SWAIT() do { if constexpr (SDEPTH == 2) asm volatile("s_waitcnt vmcnt(4)" ::: "memory"); else asm volatile("s_waitcnt vmcnt(0)" ::: "memory"); } while (0)
#define RESC(a) do { if (__any((a) < 1.f)) { if (hi == 0) al_l[r32] = (a); asm volatile("s_waitcnt lgkmcnt(0)" ::: "memory"); \
    for (int d = 0; d < 4; ++d) for (int r = 0; r < 16; ++r) o[d][r] *= al_l[crow(r, hi)]; } } while (0)
  f32x16 pA0, pA1, pB0, pB1; float mnA, mnB, alA, alB; bf16x8 pa0, pa1, pa2, pa3; const int NT = seq / KVBLK;
  constexpr int SE = 0, SO = SDEPTH - 1;
  SLOAD(SE, 0); asm volatile("s_waitcnt vmcnt(0)" ::: "memory"); SWRITE(0, SE); __syncthreads();
  qkt(pA0, pA1, K_lds, qr, r32, hi); partialSM(pA0, pA1, m_reg, mnA, alA);
  SLOAD(SO, KVBLK); if constexpr (SDEPTH == 2) { if (2 < NT) SLOAD(SE, 2 * KVBLK); }
  SWAIT(); SWRITE(1, SO); __syncthreads();
  for (int j = 1; j + 1 < NT; j += 2) {
    SBAR(); qkt(pB0, pB1, (bf16*)((char*)K_lds + SHM_K), qr, r32, hi);
    finishSM(pA0, pA1, alA, l_reg, pa0, pa1, pa2, pa3); SBAR();
    SLOAD(SO, (j + SDEPTH) * KVBLK); SBAR();
    pv_d0(o, vb0, pa0, pa1, pa2, pa3); partialSM(pB0, pB1, m_reg, mnB, alB);
    __syncthreads(); SWAIT(); SWRITE(0, SE);
    RESC(alB); __syncthreads();
    SBAR(); qkt(pA0, pA1, K_lds, qr, r32, hi);
    finishSM(pB0, pB1, alB, l_reg, pa0, pa1, pa2, pa3); SBAR();
    if (SDEPTH == 1 || j + 3 < NT) SLOAD(SE, (j + 1 + SDEPTH) * KVBLK); SBAR();
    pv_d0(o, vb0 + (int)SHM_V, pa0, pa1, pa2, pa3); partialSM(pA0, pA1, m_reg, mnA, alA);
    __syncthreads(); SWAIT(); SWRITE(1, SO);
    RESC(alA); __syncthreads();
  }
  SBAR(); qkt(pB0, pB1, (bf16*)((char*)K_lds + SHM_K), qr, r32, hi);
  finishSM(pA0, pA1, alA, l_reg, pa0, pa1, pa2, pa3); SBAR();
  pv_d0(o, vb0, pa0, pa1, pa2, pa3); partialSM(pB0, pB1, m_reg, mnB, alB);
  __syncthreads(); RESC(alB);
  finishSM(pB0, pB1, alB, l_reg, pa0, pa1, pa2, pa3); SBAR();
  pv_d0(o, vb0 + (int)SHM_V, pa0, pa1, pa2, pa3);
  if (hi == 0) li_l[r32] = l_reg; asm volatile("s_waitcnt lgkmcnt(0)" ::: "memory");
  float rli[16];
#pragma unroll
  for (int r = 0; r < 16; ++r) rli[r] = __builtin_amdgcn_rcpf(li_l[crow(r, hi)]);
  unsigned short* Ow = Ob + (long)(wid * QBLK) * LDO;
  if (Ob) {
    unsigned short zr[16][4];
#pragma unroll
    for (int r = 0; r < 16; ++r) { const int orow = crow(r, hi);
#pragma unroll
      for (int d0 = 0; d0 < 4; ++d0) zr[r][d0] = Ow[(long)orow * LDO + d0 * 32 + r32]; }
#pragma unroll
    for (int r = 0; r < 16; ++r) { const int orow = crow(r, hi);
#pragma unroll
      for (int d0 = 0; d0 < 4; ++d0) { const float z = __uint_as_float(((unsigned)zr[r][d0]) << 16);
        const float v = ATT_PROBE_K * o[d0][r] * rli[r] * z / (1.f + __expf(-z)); Ow[(long)orow * LDO + d0 * 32 + r32] = (unsigned short)(cvtpk(v, 0.f) & 0xffffu); } }
  }
#undef SLOAD
#undef SWRITE
#undef SWAIT
#undef RESC
}

}

typedef short v8s __attribute__((ext_vector_type(8)));
typedef float v4f __attribute__((ext_vector_type(4)));
typedef unsigned v4u __attribute__((ext_vector_type(4)));
#define MFMA32(a, b, c) __builtin_amdgcn_mfma_f32_32x32x16_bf16((a), (b), (c), 0, 0, 0)
typedef float f32x2_t __attribute__((ext_vector_type(2))); typedef __bf16 bf16x2_t __attribute__((ext_vector_type(2)));
__device__ __forceinline__ unsigned cvtpk2(float lo, float hi) { f32x2_t v = {lo, hi}; bf16x2_t b = __builtin_convertvector(v, bf16x2_t); return __builtin_bit_cast(unsigned, b); }
__device__ __forceinline__ int crow_(int r, int hi) { return (r & 3) + 8 * (r >> 2) + 4 * hi; }
template <int BASE> __device__ __forceinline__ v8s pk4(const f32x16& P) {
    const unsigned a0 = cvtpk2(P[BASE + 0], P[BASE + 1]), a1 = cvtpk2(P[BASE + 2], P[BASE + 3]);
    const unsigned b0 = cvtpk2(P[BASE + 4], P[BASE + 5]), b1 = cvtpk2(P[BASE + 6], P[BASE + 7]);
    auto r0 = __builtin_amdgcn_permlane32_swap(a0, b0, false, false); auto r1 = __builtin_amdgcn_permlane32_swap(a1, b1, false, false);
    v4u w = {r0[0], r1[0], r0[1], r1[1]}; return __builtin_bit_cast(v8s, w);
}

struct Args { const float* in[16]; float* out; unsigned char* ws; int ph_lo, ph_hi; };

__device__ __forceinline__ void transpose_item(const float* __restrict__ W, int N, bfu* __restrict__ WT, int K, int k0, int n0, int dn0, float* scr, int lane) {
#pragma unroll 8
    for (int i = 0; i < 32; ++i) { const int kk = 2 * i + (lane >> 5); scr[kk * 33 + (lane & 31)] = W[(size_t)(k0 + kk) * N + n0 + (lane & 31)]; }
    asm volatile("s_waitcnt lgkmcnt(0)" ::: "memory");
    const int c = lane & 7;
#pragma unroll
    for (int j = 0; j < 4; ++j) { const int n = (lane >> 3) + 8 * j; const float* s = scr + (8 * c) * 33 + n;
        v4u o; o.x = cvtpk2(s[0 * 33], s[1 * 33]); o.y = cvtpk2(s[2 * 33], s[3 * 33]); o.z = cvtpk2(s[4 * 33], s[5 * 33]); o.w = cvtpk2(s[6 * 33], s[7 * 33]);
        *(v4u*)(WT + (size_t)(dn0 + n) * K + k0 + 8 * c) = o; }
    asm volatile("s_waitcnt lgkmcnt(0)" ::: "memory");
}
__device__ __forceinline__ void phase0(const Args& a, char* lds) {
    const int tid = threadIdx.x, lane = tid & 63, wave = tid >> 6;
    unsigned char* ws = a.ws;
    if (blockIdx.x == 0) { unsigned* bw = (unsigned*)(ws + WS_BAR); for (int i = tid; i < 4096; i += 512) bw[i] = 0u; }
    if (blockIdx.x == 1 || gridDim.x == 1) { unsigned* pc = (unsigned*)(ws + WS_PCNT); for (int i = tid; i < 128 * 64; i += 512) pc[i] = 0u; }
    float* sv = (float*)lds; float* red = (float*)(lds + 24576);
    const float* c = a.in[1]; const float* cc = a.in[3]; const float* w_ada = a.in[4]; const float* b_ada = a.in[5];
    float* MOD = (float*)(ws + WS_MOD);
    if (blockIdx.x < 192) {
        for (int i = tid; i < 3 * 2048; i += 512) { const float v = i < 4096 ? c[i] : cc[i - 4096]; sv[i] = siluf(v); }
        __syncthreads();
        for (int cgp = blockIdx.x; cgp < 192; cgp += gridDim.x) {
            const int sub = tid & 7, rg = tid >> 3;
            v4f acc0 = {0.f, 0.f, 0.f, 0.f}, acc1 = acc0, acc2 = acc0;
            const float* wp = w_ada + (size_t)(rg * 32) * 6144 + cgp * 32 + sub * 4;
#pragma unroll 8
            for (int rr = 0; rr < 32; ++rr) { const v4f w = *(const v4f*)(wp + (size_t)rr * 6144); const int k = rg * 32 + rr; acc0 += sv[k] * w; acc1 += sv[2048 + k] * w; acc2 += sv[4096 + k] * w; }
            float* rp = red + rg * 96 + sub * 4;
            *(v4f*)(rp) = acc0; *(v4f*)(rp + 32) = acc1; *(v4f*)(rp + 64) = acc2;
            __syncthreads();
            if (tid < 96) { float s = 0.f; for (int g = 0; g < 64; ++g) s += red[g * 96 + tid]; const int v = tid >> 5, cix = tid & 31; MOD[v * 6144 + cgp * 32 + cix] = s + b_ada[cgp * 32 + cix]; }
            __syncthreads();
        }
    }
}
__device__ __forceinline__ void phase_wcopy(const Args& a, char* lds) {
    const int tid = threadIdx.x, lane = tid & 63, wave = tid >> 6;
    unsigned char* ws = a.ws;
    float* scr = (float*)(lds + wave * 8448);
    const int gw = blockIdx.x * 8 + wave, NGW = gridDim.x * 8;
    const float* w_in = a.in[7]; const float* w_out = a.in[14];
    bfu* WinT = (bfu*)((unsigned char*)a.out + OUT_WIN); bfu* WoutT = (bfu*)(ws + WS_WOUT);
    constexpr int I_IN = 32 * 209, I_OUT = 32 * 64;
    for (int it = gw; it < I_IN + I_OUT; it += NGW) {
        if (it < I_IN) { const int kb = it / 209, nb = it % 209, n0 = nb * 32;
            const int dn0 = n0 < 4096 ? n0 : (n0 < 4128 ? n0 + 2560 : (n0 < 5664 ? n0 + 992 : n0 - 1568));
            transpose_item(w_in, INC, WinT, DM, kb * 64, n0, dn0, scr, lane);
        } else { const int r = it - I_IN, kb = r / 64, nb = r % 64; transpose_item(w_out, DM, WoutT, DM, kb * 64, nb * 32, nb * 32, scr, lane); }
    }
    { v4u z = {0u, 0u, 0u, 0u}; v4u* pz = (v4u*)(WinT + (size_t)INC * DM); const int n16 = (NPAD - INC) * DM * 2 / 16;
      for (int i = blockIdx.x * 512 + tid; i < n16; i += gridDim.x * 512) pz[i] = z; }
}

__device__ __forceinline__ void phase1(const Args& a) {
    const int tid = threadIdx.x, lane = tid & 63, wave = tid >> 6;
    const int gw = blockIdx.x * 8 + wave, NGW = gridDim.x * 8;
    const float* x = a.in[0]; const float* ctx = a.in[2]; const float* nw = a.in[6];
    const float* MOD = (const float*)(a.ws + WS_MOD); bfu* H = (bfu*)((unsigned char*)a.out + OUT_H);
    for (int row = gw; row < MROWS; row += NGW) {
        const int b = row / TOK, tl = row - b * TOK;
        const float* src = tl < CTXL ? ctx + ((size_t)b * CTXL + tl) * DM : x + ((size_t)b * SEQ + (tl - CTXL)) * DM;
        const float* shift = MOD + (tl < CTXL ? 2 : b) * 6144; const float* scale = shift + 2048;
        v4f v[8]; float ss = 0.f;
#pragma unroll
        for (int j = 0; j < 8; ++j) { v[j] = ((const v4f*)src)[lane + 64 * j]; ss += (v[j].x * v[j].x + v[j].y * v[j].y) + (v[j].z * v[j].z + v[j].w * v[j].w); }
        const float rstd = rsqrtf(wave_sum(ss) * (1.f / DM) + EPSF);
#pragma unroll
        for (int j = 0; j < 8; ++j) { const int col = (lane + 64 * j) * 4; const v4f w = *(const v4f*)(nw + col), sc = *(const v4f*)(scale + col), sh = *(const v4f*)(shift + col);
            const v4f y = (v[j] * rstd) * w * (1.f + sc) + sh; u32x2 o; o.x = cvtpk2(y.x, y.y); o.y = cvtpk2(y.z, y.w);
            *(u32x2*)(H + (size_t)row * DM + col) = o; }
    }
}

struct EpiIn {
    static constexpr bool PERM = true, AFTER_DRAIN = false;
    bfu* qkvg; bfu* z; bfu* qkva; bfu* gates;
    __device__ __forceinline__ void operator()(const pg8::f32x4 (&acc)[2][2][4][2], const pg8::Unit& u, int wr, int wc, int fr, int fq) const {
        bfu* base; int ld, colb; const int pn = u.pn;
        if (pn < 12) { base = qkvg; ld = 3072; colb = pn * 256; } else if (pn < 20) { base = z; ld = 2048; colb = (pn - 12) * 256; }
        else if (pn < 26) { base = qkva; ld = 1536; colb = (pn - 20) * 256; } else { base = gates; ld = 32; colb = 0; }
        const bool gt = pn >= 26;
        const int row0 = u.pm * 256 + wr * 64 + fr, col0 = colb + wc * 32 + 8 * fq;
#pragma unroll
        for (int ai = 0; ai < 2; ++ai)
#pragma unroll
            for (int m = 0; m < 4; ++m) { bfu* rowp = base + (size_t)(row0 + ai * 128 + m * 16) * ld + col0;
#pragma unroll
                for (int bj = 0; bj < 2; ++bj) { const pg8::f32x4 v0 = acc[ai][bj][m][0], v1 = acc[ai][bj][m][1];
                    v4u w; w.x = cvtpk2(v0[0], v0[1]); w.y = cvtpk2(v0[2], v0[3]); w.z = cvtpk2(v1[0], v1[1]); w.w = cvtpk2(v1[2], v1[3]);
                    if (!gt) *(v4u*)(rowp + bj * 128) = w; else if (bj == 0 && wc == 0) *(v4u*)(rowp) = w; } }
    }
};
struct EpiOut {
    static constexpr bool PERM = false, AFTER_DRAIN = false;
    const float* x; const float* mod; float* out;
    __device__ __forceinline__ void operator()(const pg8::f32x4 (&acc)[2][2][4][2], const pg8::Unit& u, int wr, int wc, int fr, int fq) const {
        const int b = u.pm >= 65 ? 1 : 0; const float* gate = mod + b * 6144 + 4096;
        const int col0 = u.pn * 256 + wc * 32 + 4 * fq;
        v4f g[2][2];
#pragma unroll
        for (int bj = 0; bj < 2; ++bj)
#pragma unroll
            for (int n = 0; n < 2; ++n) g[bj][n] = *(const v4f*)(gate + col0 + bj * 128 + n * 16);
#pragma unroll
        for (int ai = 0; ai < 2; ++ai) {
            v4f xv[4][2][2];
#pragma unroll
            for (int m = 0; m < 4; ++m) { const int row = u.pm * 256 + ai * 128 + wr * 64 + m * 16 + fr; const size_t off = (size_t)(row - 256 * (b + 1)) * DM + col0;
#pragma unroll
                for (int bj = 0; bj < 2; ++bj)
#pragma unroll
                    for (int n = 0; n < 2; ++n) xv[m][bj][n] = *(const v4f*)(x + off + bj * 128 + n * 16); }
#pragma unroll
            for (int m = 0; m < 4; ++m) { const int row = u.pm * 256 + ai * 128 + wr * 64 + m * 16 + fr; const size_t off = (size_t)(row - 256 * (b + 1)) * DM + col0;
#pragma unroll
                for (int bj = 0; bj < 2; ++bj)
#pragma unroll
                    for (int n = 0; n < 2; ++n) { const pg8::f32x4 av = acc[ai][bj][m][n]; const v4f xx = xv[m][bj][n], gg = g[bj][n]; v4f o;
                        o.x = xx.x + gg.x * av[0]; o.y = xx.y + gg.y * av[1]; o.z = xx.z + gg.z * av[2]; o.w = xx.w + gg.w * av[3];
                        *(v4f*)(out + off + bj * 128 + n * 16) = o; } }
        }
    }
};
struct EpiOutNorm {
    static constexpr bool PERM = false, AFTER_DRAIN = false;
    const float* x; const float* mod; const float* fw; float* out; float* xbuf; unsigned* pcnt; char* lds;
    __device__ __forceinline__ void operator()(pg8::f32x4 (&acc)[2][2][4][2], const pg8::Unit& u, int wr, int wc, int fr, int fq) const {
        const int tid = threadIdx.x, lane = tid & 63, wid = __builtin_amdgcn_readfirstlane(tid >> 6);
        const int b = u.pm >= 65 ? 1 : 0; const float* gate = mod + b * 6144 + 4096; const int pml = u.pm - 1 - b;
        const int col0 = u.pn * 256 + wc * 32 + 4 * fq;
        float* P = (float*)(lds); float* S = (float*)(lds + 4096); volatile unsigned* flag = (volatile unsigned*)(lds + 5120);
        v4f g[2][2];
#pragma unroll
        for (int bj = 0; bj < 2; ++bj)
#pragma unroll
            for (int n = 0; n < 2; ++n) g[bj][n] = *(const v4f*)(gate + col0 + bj * 128 + n * 16);
#pragma unroll
        for (int ai = 0; ai < 2; ++ai) {
            v4f xv[4][2][2];
#pragma unroll
            for (int m = 0; m < 4; ++m) { const size_t off = (size_t)(pml * 256 + ai * 128 + wr * 64 + m * 16 + fr) * DM + col0;
#pragma unroll
                for (int bj = 0; bj < 2; ++bj)
#pragma unroll
                    for (int n = 0; n < 2; ++n) xv[m][bj][n] = *(const v4f*)(x + off + bj * 128 + n * 16); }
#pragma unroll
            for (int m = 0; m < 4; ++m) { float sq = 0.f;
#pragma unroll
                for (int bj = 0; bj < 2; ++bj)
#pragma unroll
                    for (int n = 0; n < 2; ++n) { pg8::f32x4 av = acc[ai][bj][m][n]; const v4f xx = xv[m][bj][n], gg = g[bj][n];
                        av[0] = xx.x + gg.x * av[0]; av[1] = xx.y + gg.y * av[1]; av[2] = xx.z + gg.z * av[2]; av[3] = xx.w + gg.w * av[3];
                        sq += (av[0] * av[0] + av[1] * av[1]) + (av[2] * av[2] + av[3] * av[3]); acc[ai][bj][m][n] = av; }
                sq += __shfl_xor(sq, 16); sq += __shfl_xor(sq, 32);
                if (fq == 0) P[(ai * 128 + wr * 64 + m * 16 + fr) * 4 + wc] = sq; }
        }
        asm volatile("s_waitcnt lgkmcnt(0)" ::: "memory"); __builtin_amdgcn_s_barrier(); asm volatile("" ::: "memory");
        unsigned* cnt = pcnt + 64 * pml;
        if (tid < 256) { const float tot = (P[tid * 4 + 0] + P[tid * 4 + 1]) + (P[tid * 4 + 2] + P[tid * 4 + 3]);
            __hip_atomic_store(xbuf + ((size_t)pml * 256 + tid) * 8 + u.pn, tot, __ATOMIC_RELAXED, __HIP_MEMORY_SCOPE_AGENT); }
        asm volatile("s_waitcnt vmcnt(0)" ::: "memory");
        if (wid < 4 && lane == 0) __hip_atomic_fetch_add(cnt, 1u, __ATOMIC_RELAXED, __HIP_MEMORY_SCOPE_AGENT);
        if (wid == 0) { unsigned spins = 0u;
            for (;;) { if ((unsigned)__builtin_amdgcn_readfirstlane(__hip_atomic_load(cnt, __ATOMIC_RELAXED, __HIP_MEMORY_SCOPE_AGENT)) >= 32u) break;
                if (++spins > (1u << 18)) break; __builtin_amdgcn_s_sleep(2); }
            __builtin_amdgcn_fence(__ATOMIC_ACQUIRE, "agent");
            if (lane == 0) *flag = spins; }
        asm volatile("s_waitcnt vmcnt(0) lgkmcnt(0)" ::: "memory"); __builtin_amdgcn_s_barrier(); asm volatile("" ::: "memory");
        if (tid < 256) { const float* sl = xbuf + ((size_t)pml * 256 + tid) * 8; float t8 = 0.f;
#pragma unroll
            for (int p = 0; p < 8; ++p) t8 += __hip_atomic_load(sl + p, __ATOMIC_RELAXED, __HIP_MEMORY_SCOPE_AGENT);
            S[tid] = rsqrtf(t8 * (1.f / DM) + EPSF); }
        asm volatile("s_waitcnt vmcnt(0) lgkmcnt(0)" ::: "memory"); __builtin_amdgcn_s_barrier(); asm volatile("" ::: "memory");
        v4f w4[2][2];
#pragma unroll
        for (int bj = 0; bj < 2; ++bj)
#pragma unroll
            for (int n = 0; n < 2; ++n) w4[bj][n] = *(const v4f*)(fw + col0 + bj * 128 + n * 16);
#pragma unroll
        for (int ai = 0; ai < 2; ++ai)
#pragma unroll
            for (int m = 0; m < 4; ++m) { const int r = ai * 128 + wr * 64 + m * 16 + fr; const float rs = S[r]; const size_t off = (size_t)(pml * 256 + r) * DM + col0;
#pragma unroll
                for (int bj = 0; bj < 2; ++bj)
#pragma unroll
                    for (int n = 0; n < 2; ++n) { const pg8::f32x4 av = acc[ai][bj][m][n]; const v4f ww = w4[bj][n]; v4f o;
                        o.x = av[0] * rs * ww.x; o.y = av[1] * rs * ww.y; o.z = av[2] * rs * ww.z; o.w = av[3] * rs * ww.w;
                        *(v4f*)(out + off + bj * 128 + n * 16) = o; } }
        asm volatile("s_waitcnt lgkmcnt(0)" ::: "memory");
    }
};
struct OutOrderN { int G, vc;
    __device__ __forceinline__ bool next(int i, pg8::Unit& u) const { const int L = i * G + vc; if (L >= 1024) return false; const int p = L >> 3; u.pm = p < 64 ? p + 1 : p + 2; u.pn = L & 7; return true; }
    __device__ __forceinline__ void a_ready(const pg8::Unit&) const {}
    __device__ __forceinline__ void done(const pg8::Unit&) const {}
};
struct OutOrder { pg8::StaticOrder so;
    __device__ __forceinline__ bool next(int i, pg8::Unit& u) const { if (!so.next(i, u)) return false; u.pm = u.pm < 64 ? u.pm + 1 : u.pm + 2; return true; }
    __device__ __forceinline__ void a_ready(const pg8::Unit&) const {}
    __device__ __forceinline__ void done(const pg8::Unit&) const {}
};

struct InOrder { pg8::StaticOrder so; int limit, mode;
    __device__ __forceinline__ bool next(int i, pg8::Unit& u) const { if ((long)i * so.G + so.c >= limit) return false; if (!so.next(i, u)) return false; u.pn = mode ? u.pn + 12 : (u.pn < 12 ? u.pn : 26); return true; }
    __device__ __forceinline__ void a_ready(const pg8::Unit&) const {}
    __device__ __forceinline__ void done(const pg8::Unit&) const {}
};
__device__ __forceinline__ void phase3a(const Args& a) {
    const int tid = threadIdx.x, lane = tid & 63, wave = tid >> 6;
    const int gw = blockIdx.x * 8 + wave, NGW = gridDim.x * 8;
    bfu* QKVA = (bfu*)(a.ws + WS_QKVA); const float* qnw = a.in[12]; const float* knw = a.in[13];
    const int ax = lane >> 5, i = lane & 31, d1 = ax * 64 + i, d2 = d1 + 32;
    const float inv = exp2f(-(float)i * (13.287712379549449f / 32.f));
    const float qw1 = qnw[d1], qw2 = qnw[d2], kw1 = knw[d1], kw2 = knw[d2];
    for (int row = gw; row < MROWS; row += NGW) {
        const int b = row / TOK, tl = row - b * TOK; const bool isctx = tl < CTXL; const int t = tl - CTXL;
        float cs = 1.f, sn = 0.f;
        if (!isctx) { const float pos = (float)(ax == 0 ? (t >> 6) : (t & 63)); const float ang = pos * inv; float rev = ang * 0.15915494309189535f; rev -= floorf(rev);
            sn = __builtin_amdgcn_sinf(rev); cs = __builtin_amdgcn_cosf(rev); }
        bfu* base = QKVA + (size_t)row * 1536;
        { bfu* VC = (bfu*)(a.ws + WS_VC);
#pragma unroll
          for (int kv = 0; kv < 2; ++kv) *(unsigned*)(VC + ((size_t)(b * 2 + kv) * TOK + tl) * 128 + 2 * lane) = *(const unsigned*)(base + 1280 + kv * 128 + 2 * lane); }
        float xa[10], xb[10];
#pragma unroll
        for (int hh = 0; hh < 10; ++hh) { xa[hh] = bf2f(base[hh * 128 + d1]); xb[hh] = bf2f(base[hh * 128 + d2]); }
#pragma unroll
        for (int hh = 0; hh < 10; ++hh) { bfu* p = base + hh * 128;
            const float x1 = xa[hh], x2 = xb[hh];
            const float r = rsqrtf(wave_sum(x1 * x1 + x2 * x2) * (1.f / 128.f) + EPSF);
            const float y1 = x1 * r * (hh < 8 ? qw1 : kw1), y2 = x2 * r * (hh < 8 ? qw2 : kw2);
            const float o1 = y1 * cs - y2 * sn, o2 = y2 * cs + y1 * sn;
            bfu* q = hh < 8 ? p : (bfu*)(a.ws + WS_KC) + ((size_t)(b * 2 + (hh - 8)) * TOK + tl) * 128;
            q[d1] = (bfu)(cvtpk2(o1, 0.f) & 0xffffu); q[d2] = (bfu)(cvtpk2(o2, 0.f) & 0xffffu); }
    }
}

constexpr int PL_QS = 0, PL_KS = 17408, PL_KST = 34816, PL_VST = 53248, PL_AMAT = 71680, PL_TU = 104448, PL_SM = 141312;
__device__ __forceinline__ void prep_load(const Args& a, int it, unsigned (&raw)[12][3], float (&cw)[5][3][2], float (&gpre)[4]) {
    int tid_o = threadIdx.x; asm volatile("" : "+v"(tid_o));
    const int tid = tid_o, lane = tid & 63, wave = __builtin_amdgcn_readfirstlane(tid >> 6);
    const int b = it / (GH * NCH), h = (it / NCH) % GH, cidx = it % NCH;
    const int rowbase = b * TOK + (cidx < 4 ? cidx * 64 : CTXL + (cidx - 4) * 64);
    const int seg_lo = b * TOK + (cidx < 4 ? 0 : CTXL), seg_hi = cidx < 4 ? b * TOK + CTXL : (b + 1) * TOK;
    const bfu* QKVG = (const bfu*)(a.ws + WS_QKVG); const bfu* GATES = (const bfu*)(a.ws + WS_GATES);
    const float* conv_w = a.in[8];
#pragma unroll
    for (int j = 0; j < 5; ++j)
#pragma unroll
        for (int s = 0; s < 3; ++s) { const float* p = conv_w + j * 3072 + s * 1024 + h * 128 + 2 * lane; cw[j][s][0] = p[0]; cw[j][s][1] = p[1]; }
    const int t0 = wave * 8;
#pragma unroll
    for (int rr = 0; rr < 12; ++rr) { const int rg = rowbase + t0 - 2 + rr; const bool ok = rg >= seg_lo && rg < seg_hi;
#pragma unroll
        for (int s = 0; s < 3; ++s) raw[rr][s] = ok ? *(const unsigned*)(QKVG + (size_t)rg * 3072 + s * 1024 + h * 128 + 2 * lane) : 0u; }
    { const bfu* gp = GATES + (size_t)(rowbase + lane) * 32 + h; gpre[0] = bf2f(gp[0]); gpre[1] = bf2f(gp[8]); gpre[2] = bf2f(gp[16]); gpre[3] = bf2f(gp[24]); }
}
#define PBAR() do { asm volatile("s_waitcnt lgkmcnt(0)" ::: "memory"); __builtin_amdgcn_s_barrier(); asm volatile("" ::: "memory"); } while (0)
__device__ __forceinline__ void prep_item(const Args& a, char* lds, int it, int it_next, unsigned (&raw)[12][3], float (&cw)[5][3][2], float (&gpre)[4]) {
    int tid_o = threadIdx.x; asm volatile("" : "+v"(tid_o));
    const int tid = tid_o, lane = tid & 63, wave = __builtin_amdgcn_readfirstlane(tid >> 6);
    const int h = (it / NCH) % GH;
    unsigned char* item = a.ws + WS_FRAG + (size_t)it * ITEM_BYTES;
    bfu* QS = (bfu*)(lds + PL_QS); bfu* KS = (bfu*)(lds + PL_KS); bfu* KST = (bfu*)(lds + PL_KST); bfu* VST = (bfu*)(lds + PL_VST);
    float* SM = (float*)(lds + PL_SM);
    const int hi = lane >> 5, n32 = lane & 31;
    {
        const int t0 = wave * 8;
        float yq[8][2], yk[8][2], yv[8][2], sq[8], sk[8];
#pragma unroll
        for (int tt = 0; tt < 8; ++tt) {
            float y[3][2];
#pragma unroll
            for (int s = 0; s < 3; ++s) { float a0 = 0.f, a1 = 0.f;
#pragma unroll
                for (int j = 0; j < 5; ++j) { a0 += bflo(raw[tt + j][s]) * cw[j][s][0]; a1 += bfhi(raw[tt + j][s]) * cw[j][s][1]; }
                y[s][0] = siluf(a0); y[s][1] = siluf(a1); }
            yq[tt][0] = y[0][0]; yq[tt][1] = y[0][1]; yk[tt][0] = y[1][0]; yk[tt][1] = y[1][1]; yv[tt][0] = y[2][0]; yv[tt][1] = y[2][1];
            sq[tt] = y[0][0] * y[0][0] + y[0][1] * y[0][1]; sk[tt] = y[1][0] * y[1][0] + y[1][1] * y[1][1]; }
#pragma unroll
        for (int o = 1; o < 64; o <<= 1) {
#pragma unroll
            for (int tt = 0; tt < 8; ++tt) { sq[tt] += __shfl_xor(sq[tt], o); sk[tt] += __shfl_xor(sk[tt], o); } }
        unsigned kpk[8], vpk[8];
#pragma unroll
        for (int tt = 0; tt < 8; ++tt) { const int t = t0 + tt;
            const float rq = rsqrtf(sq[tt] + EPSF) * 0.08838834764831845f, rk = rsqrtf(sk[tt] + EPSF);
            const unsigned qp = cvtpk2(yq[tt][0] * rq, yq[tt][1] * rq); kpk[tt] = cvtpk2(yk[tt][0] * rk, yk[tt][1] * rk); vpk[tt] = cvtpk2(yv[tt][0], yv[tt][1]);
            *(unsigned*)(QS + t * 136 + 2 * lane) = qp; *(unsigned*)(KS + t * 136 + 2 * lane) = kpk[tt]; }
        {
            v4u k0, k1, v0, v1;
#pragma unroll
            for (int i = 0; i < 4; ++i) { k0[i] = (kpk[2 * i] & 0xffffu) | (kpk[2 * i + 1] << 16); k1[i] = (kpk[2 * i] >> 16) | (kpk[2 * i + 1] & 0xffff0000u);
                v0[i] = (vpk[2 * i] & 0xffffu) | (vpk[2 * i + 1] << 16); v1[i] = (vpk[2 * i] >> 16) | (vpk[2 * i + 1] & 0xffff0000u); }
            *(v4u*)(KST + (2 * lane) * 72 + t0) = k0; *(v4u*)(KST + (2 * lane + 1) * 72 + t0) = k1;
            *(v4u*)(VST + (2 * lane) * 72 + t0) = v0; *(v4u*)(VST + (2 * lane + 1) * 72 + t0) = v1; }
        {
            const float af = gpre[2] + a.in[10][h], ab = gpre[3] + a.in[10][8 + h];
            const float gf0 = -__expf(a.in[9][h]) * (fmaxf(af, 0.f) + log1pf(__expf(-fabsf(af)))), gb0 = -__expf(a.in[9][8 + h]) * (fmaxf(ab, 0.f) + log1pf(__expf(-fabsf(ab))));
            float xf = gf0, xb = gb0;
#pragma unroll
            for (int off = 1; off < 64; off <<= 1) { const float yf = __shfl_up(xf, off), yb = __shfl_down(xb, off); if (lane >= off) xf += yf; if (lane + off < 64) xb += yb; }
            const float glf = __shfl(xf, 63), glb = __shfl(xb, 0);
            if (wave < 2) { const int dir = wave; const float xg = dir ? xb : xf, gl = dir ? glb : glf, beta = 1.f / (1.f + __expf(-(dir ? gpre[1] : gpre[0])));
                const float eg = __expf(xg), ek = __expf(gl - xg);
                SM[dir * 64 + lane] = beta; SM[256 + dir * 64 + lane] = xg;
                float* SC = (float*)(item + 32768 + dir * DIR_BYTES + 24576); SC[lane] = eg; SC[64 + lane] = ek; SC[192 + lane] = beta; if (lane == 0) SC[128] = __expf(gl); } }
        if (it_next >= 0) prep_load(a, it_next, raw, cw, gpre);
    }
    PBAR();
#pragma unroll
    for (int p = 0; p < 4; ++p) { const int ci = tid + 512 * p, f = ci >> 6, ln = ci & 63, r = ln & 31, hh = ln >> 5; const bfu* src;
        if (f < 16) { const int mt = f >> 3, ks = f & 7; src = QS + (32 * mt + r) * 136 + 16 * ks + 8 * hh; }
        else { const int f2 = f - 16, mt = f2 >> 2, ks = f2 & 3; src = KST + (32 * mt + r) * 72 + 16 * ks + 8 * hh; }
        *(v4u*)(item + (size_t)ci * 16) = *(const v4u*)src; }
#pragma unroll
    for (int p = 0; p < 2; ++p) { const int ci = tid + 512 * p, f = ci >> 6, ln = ci & 63, r = ln & 31, hh = ln >> 5, nt = f >> 2, ks = f & 3;
        const v4u vv = *(const v4u*)(VST + (32 * nt + r) * 72 + 16 * ks + 8 * hh);
        *(v4u*)(item + 32768 + (size_t)ci * 16) = vv; *(v4u*)(item + 32768 + DIR_BYTES + (size_t)ci * 16) = vv; }
    { const int which = wave >> 2, ti = (wave >> 1) & 1, tj = wave & 1; f32x16 c = {};
      if (which == 0) {
#pragma unroll
          for (int ks = 0; ks < 8; ++ks) { const v8s af = *(const v8s*)(KS + (32 * ti + n32) * 136 + 16 * ks + 8 * hi), bf = *(const v8s*)(KS + (32 * tj + n32) * 136 + 16 * ks + 8 * hi); c = MFMA32(af, bf, c); }
          const int j = 32 * tj + n32;
#pragma unroll 1
          for (int dir = 0; dir < 2; ++dir) { const float gj = SM[256 + dir * 64 + j]; const int lj = dir ? 63 - j : j;
#pragma unroll
              for (int r = 0; r < 16; ++r) { const int i = 32 * ti + crow_(r, hi); const bool cond = dir ? (j > i) : (j < i);
                  const float v = cond ? SM[dir * 64 + i] * c[r] * __expf(fminf(SM[256 + dir * 64 + i] - gj, 0.f)) : 0.f; const int li = dir ? 63 - i : i;
                  ((float*)(item + 32768 + dir * DIR_BYTES + 25600))[li * 64 + lj] = v; } }
      } else {
#pragma unroll
          for (int ks = 0; ks < 8; ++ks) { const v8s af = *(const v8s*)(KS + (32 * tj + n32) * 136 + 16 * ks + 8 * hi), bf = *(const v8s*)(QS + (32 * ti + n32) * 136 + 16 * ks + 8 * hi); c = MFMA32(af, bf, c); }
          const int i = 32 * ti + n32;
#pragma unroll 1
          for (int dir = 0; dir < 2; ++dir) { const float gi = SM[256 + dir * 64 + i]; f32x16 p;
#pragma unroll
              for (int r = 0; r < 16; ++r) { const int j = 32 * tj + crow_(r, hi); const bool cond = dir ? (j >= i) : (j <= i);
                  p[r] = cond ? c[r] * __expf(fminf(gi - SM[256 + dir * 64 + j], 0.f)) : 0.f; }
              unsigned char* dst = item + 32768 + dir * DIR_BYTES + 16384;
              *(v8s*)(dst + ((ti * 4 + 2 * tj + 0) * 64 + lane) * 16) = pk4<0>(p); *(v8s*)(dst + ((ti * 4 + 2 * tj + 1) * 64 + lane) * 16) = pk4<8>(p); }
      } }
    PBAR();
}
__device__ __forceinline__ int tswz(int row, int col) { return row * 128 + ((((col >> 3) ^ (row & 7))) << 4) + (col & 7) * 2; }
__device__ __forceinline__ void prep_part2(const Args& a, char* lds, int it, int dir) {
    int tid_o = threadIdx.x; asm volatile("" : "+v"(tid_o));
    const int lane = tid_o & 63, wave = __builtin_amdgcn_readfirstlane(tid_o >> 6), hi = lane >> 5, n32 = lane & 31;
    unsigned char* item = a.ws + WS_FRAG + (size_t)it * ITEM_BYTES; unsigned char* dbase = item + 32768 + dir * DIR_BYTES;
    char* wl = lds + wave * 16384; float* Am = (float*)wl;
    { const v4f* Ag = (const v4f*)(dbase + 25600); v4f t_[16];
#pragma unroll
      for (int i = 0; i < 16; ++i) t_[i] = Ag[lane + 64 * i];
#pragma unroll
      for (int i = 0; i < 16; ++i) ((v4f*)Am)[lane + 64 * i] = t_[i]; }
    const float* SC = (const float*)(dbase + 24576);
    const int oc = dir ? 63 - lane : lane; const float bc = SC[192 + oc], bw = -bc * SC[oc];
    asm volatile("s_waitcnt vmcnt(0) lgkmcnt(0)" ::: "memory");
    float T[64];
#pragma unroll
    for (int i = 0; i < 64; ++i) T[i] = 0.f;
#pragma unroll
    for (int i = 0; i < 64; ++i) { float acc = (i == lane) ? 1.f : 0.f;
#pragma unroll
        for (int j4 = 0; j4 < (i + 3) / 4; ++j4) { const v4f av = *(const v4f*)(Am + i * 64 + 4 * j4);
            acc -= av.x * T[4 * j4]; acc -= av.y * T[4 * j4 + 1]; acc -= av.z * T[4 * j4 + 2]; acc -= av.w * T[4 * j4 + 3]; }
        T[i] = acc; asm volatile("" ::: "memory"); __builtin_amdgcn_sched_barrier(0); }
    asm volatile("s_waitcnt lgkmcnt(0)" ::: "memory");
    char* TU = wl; char* TW = wl + 8192;
#pragma unroll
    for (int i = 0; i < 64; ++i) { const int oi = dir ? 63 - i : i; const unsigned w = cvtpk2(T[i] * bc, T[i] * bw); *(bfu*)(TU + tswz(oi, oc)) = (bfu)(w & 0xffffu); *(bfu*)(TW + tswz(oi, oc)) = (bfu)(w >> 16); }
    asm volatile("s_waitcnt lgkmcnt(0)" ::: "memory");
#pragma unroll 1
    for (int nt = 0; nt < 4; ++nt) { v8s vf[4];
#pragma unroll
        for (int ks = 0; ks < 4; ++ks) vf[ks] = *(const v8s*)(dbase + ((nt * 4 + ks) * 64 + lane) * 16);
#pragma unroll
        for (int mt = 0; mt < 2; ++mt) { f32x16 c = {};
#pragma unroll
            for (int ks = 0; ks < 4; ++ks) { const v8s af = *(const v8s*)(TU + tswz(32 * mt + n32, 16 * ks + 8 * hi)); c = MFMA32(af, vf[ks], c); }
            v4u w0, w1; w0.x = cvtpk2(c[0], c[1]); w0.y = cvtpk2(c[2], c[3]); w0.z = cvtpk2(c[4], c[5]); w0.w = cvtpk2(c[6], c[7]);
            w1.x = cvtpk2(c[8], c[9]); w1.y = cvtpk2(c[10], c[11]); w1.z = cvtpk2(c[12], c[13]); w1.w = cvtpk2(c[14], c[15]);
            unsigned char* up = dbase + 25600 + ((nt * 2 + mt) * 64 + lane) * 32; *(v4u*)up = w0; *(v4u*)(up + 16) = w1; } }
    v8s wout[16];
#pragma unroll
    for (int nt = 0; nt < 4; ++nt) { v8s kf[4];
#pragma unroll
        for (int ks = 0; ks < 4; ++ks) kf[ks] = *(const v8s*)(item + 16384 + ((nt * 4 + ks) * 64 + lane) * 16);
#pragma unroll
        for (int mt = 0; mt < 2; ++mt) { f32x16 c = {};
#pragma unroll
            for (int ks = 0; ks < 4; ++ks) { const v8s bf = *(const v8s*)(TW + tswz(32 * mt + n32, 16 * ks + 8 * hi)); c = MFMA32(kf[ks], bf, c); }
            wout[(mt * 4 + nt) * 2 + 0] = pk4<0>(c); wout[(mt * 4 + nt) * 2 + 1] = pk4<8>(c); } }
#pragma unroll
    for (int f = 0; f < 16; ++f) *(v8s*)(dbase + (f * 64 + lane) * 16) = wout[f];
    asm volatile("s_waitcnt vmcnt(0) lgkmcnt(0)" ::: "memory");
}

__device__ __forceinline__ int cidx_of(int step, int dir) { return dir == 0 ? step : (step < 4 ? 3 - step : 263 - step); }
constexpr int SBUF = 32768 + 25600 + 16384;
__device__ __forceinline__ void scan_step(const char* bufp, bool store, bfu* op, int wsl, f32x16& S0, f32x16& S1, f32x16& S2, f32x16& S3, v8s (&Sb)[8], int lane, int hi) {
    f32x16 vn0, vn1, oq0 = {}, oq1 = {};
    v4u ureg[4]; { const char* up = bufp + 58368 + ((wsl * 2) * 64 + lane) * 32; ureg[0] = *(const v4u*)up; ureg[1] = *(const v4u*)(up + 16); ureg[2] = *(const v4u*)(up + 2048); ureg[3] = *(const v4u*)(up + 2048 + 16); }
#pragma unroll
    for (int i = 0; i < 4; ++i) { vn0[2 * i] = bflo(ureg[0][i]); vn0[2 * i + 1] = bfhi(ureg[0][i]); vn0[8 + 2 * i] = bflo(ureg[1][i]); vn0[8 + 2 * i + 1] = bfhi(ureg[1][i]);
        vn1[2 * i] = bflo(ureg[2][i]); vn1[2 * i + 1] = bfhi(ureg[2][i]); vn1[8 + 2 * i] = bflo(ureg[3][i]); vn1[8 + 2 * i + 1] = bfhi(ureg[3][i]); }
#pragma unroll
    for (int ks = 0; ks < 8; ++ks) {
        const v8s w0 = *(const v8s*)(bufp + 32768 + (ks) * 1024 + lane * 16), w1 = *(const v8s*)(bufp + 32768 + (8 + ks) * 1024 + lane * 16);
        const v8s q0 = *(const v8s*)(bufp + (ks) * 1024 + lane * 16), q1 = *(const v8s*)(bufp + (8 + ks) * 1024 + lane * 16);
        vn0 = MFMA32(w0, Sb[ks], vn0); vn1 = MFMA32(w1, Sb[ks], vn1); oq0 = MFMA32(q0, Sb[ks], oq0); oq1 = MFMA32(q1, Sb[ks], oq1); }
    const float* SC = (const float*)(bufp + 57344);
    f32x16 vs0, vs1;
#pragma unroll
    for (int q = 0; q < 4; ++q) { const v4f e0 = *(const v4f*)(SC + 64 + 8 * q + 4 * hi), e1 = *(const v4f*)(SC + 64 + 32 + 8 * q + 4 * hi);
        const v4f g0 = *(const v4f*)(SC + 8 * q + 4 * hi), g1 = *(const v4f*)(SC + 32 + 8 * q + 4 * hi);
#pragma unroll
        for (int j = 0; j < 4; ++j) { vs0[4 * q + j] = vn0[4 * q + j] * e0[j]; vs1[4 * q + j] = vn1[4 * q + j] * e1[j]; oq0[4 * q + j] *= g0[j]; oq1[4 * q + j] *= g1[j]; } }
    v8s Vb[4], Vs[4];
    Vb[0] = pk4<0>(vn0); Vb[1] = pk4<8>(vn0); Vb[2] = pk4<0>(vn1); Vb[3] = pk4<8>(vn1);
    Vs[0] = pk4<0>(vs0); Vs[1] = pk4<8>(vs0); Vs[2] = pk4<0>(vs1); Vs[3] = pk4<8>(vs1);
    const float eL = SC[128];
    S0 = S0 * eL; S1 = S1 * eL; S2 = S2 * eL; S3 = S3 * eL;
#pragma unroll
    for (int ks = 0; ks < 4; ++ks) {
        const v8s k0 = *(const v8s*)(bufp + 16384 + (0 * 4 + ks) * 1024 + lane * 16), k1 = *(const v8s*)(bufp + 16384 + (1 * 4 + ks) * 1024 + lane * 16);
        const v8s k2 = *(const v8s*)(bufp + 16384 + (2 * 4 + ks) * 1024 + lane * 16), k3 = *(const v8s*)(bufp + 16384 + (3 * 4 + ks) * 1024 + lane * 16);
        const v8s i0 = *(const v8s*)(bufp + 49152 + (ks) * 1024 + lane * 16), i1 = *(const v8s*)(bufp + 49152 + (4 + ks) * 1024 + lane * 16);
        S0 = MFMA32(k0, Vs[ks], S0); S1 = MFMA32(k1, Vs[ks], S1); S2 = MFMA32(k2, Vs[ks], S2); S3 = MFMA32(k3, Vs[ks], S3);
        oq0 = MFMA32(i0, Vb[ks], oq0); oq1 = MFMA32(i1, Vb[ks], oq1); }
    Sb[0] = pk4<0>(S0); Sb[1] = pk4<8>(S0); Sb[2] = pk4<0>(S1); Sb[3] = pk4<8>(S1); Sb[4] = pk4<0>(S2); Sb[5] = pk4<8>(S2); Sb[6] = pk4<0>(S3); Sb[7] = pk4<8>(S3);
    if (store) {
#pragma unroll
        for (int r = 0; r < 16; ++r) { const int t = crow_(r, hi); op[(size_t)t * 1024] = (bfu)(cvtpk2(oq0[r], 0.f) & 0xffffu); op[(size_t)(32 + t) * 1024] = (bfu)(cvtpk2(oq1[r], 0.f) & 0xffffu); } }
}
__device__ __forceinline__ void scan_item(const Args& a, char* lds, int sid) {
    const int tid = threadIdx.x, lane = tid & 63, wave = tid >> 6, hi = lane >> 5, n32 = lane & 31;
    const int chain = sid >> 1, half = sid & 1;
    const int b = chain >> 4, h = (chain >> 1) & 7, dir = chain & 1;
    const unsigned char* frag0 = a.ws + WS_FRAG + (size_t)((b * GH + h) * NCH) * ITEM_BYTES;
    bfu* OG = (bfu*)(a.ws + WS_QKVG) + (size_t)dir * NB * SEQ * 1024;
    const bool loader = wave >= 4, idler = (wave == 2 || wave == 3); const int lt = tid - 256, wsl = half * 2 + wave;
#define LD_ISSUE(ST, step) do { const unsigned char* itp = frag0 + (size_t)cidx_of((step), dir) * ITEM_BYTES; const unsigned char* dp = itp + dir * DIR_BYTES; \
        _Pragma("unroll") for (int p = 0; p < 8; ++p) ST[p] = *(const v4u*)(itp + p * 4096 + lt * 16); \
        _Pragma("unroll") for (int p = 8; p < 18; ++p) ST[p] = *(const v4u*)(dp + p * 4096 + lt * 16); \
        if (lt < 64) ST[18] = *(const v4u*)(dp + 18 * 4096 + lt * 16); } while (0)
#define LD_WRITE(ST, bi) do { char* d = lds + (bi) * SBUF; _Pragma("unroll") for (int p = 0; p < 18; ++p) *(v4u*)(d + p * 4096 + lt * 16) = ST[p]; if (lt < 64) *(v4u*)(d + 18 * 4096 + lt * 16) = ST[18]; } while (0)
#define U_ISSUE(UR, step) do { const unsigned char* up = frag0 + (size_t)cidx_of((step), dir) * ITEM_BYTES + 32768 + dir * DIR_BYTES + 25600 + ((wsl * 2) * 64 + lane) * 32; \
        UR[0] = *(const v4u*)up; UR[1] = *(const v4u*)(up + 16); UR[2] = *(const v4u*)(up + 2048); UR[3] = *(const v4u*)(up + 2048 + 16); } while (0)
#define LBAR() do { asm volatile("s_waitcnt lgkmcnt(0)" ::: "memory"); __builtin_amdgcn_s_barrier(); asm volatile("" ::: "memory"); } while (0)
    if (loader) {
        v4u r0[19], r1[19];
        LD_ISSUE(r0, 0); LD_ISSUE(r1, 1); LD_WRITE(r0, 0); LD_ISSUE(r0, 2);
        for (int step = 0; step < NCH; step += 2) {
            LBAR();
            LD_WRITE(r1, 1); if (step + 3 < NCH) LD_ISSUE(r1, step + 3);
            LBAR();
            if (step + 2 < NCH) { LD_WRITE(r0, 0); if (step + 4 < NCH) LD_ISSUE(r0, step + 4); }
        }
    } else if (idler) {
        for (int step = 0; step < NCH; step += 2) { LBAR(); LBAR(); }
    } else {
        f32x16 S0 = {}, S1 = {}, S2 = {}, S3 = {}; v8s Sb[8];
#pragma unroll
        for (int i = 0; i < 8; ++i) Sb[i] = (v8s){0, 0, 0, 0, 0, 0, 0, 0};
        bfu* obase = OG + (size_t)b * SEQ * 1024 + h * 128 + 32 * wsl + n32;
        for (int step = 0; step < NCH; step += 2) {
            LBAR();
            { const int cidx = cidx_of(step, dir); scan_step(lds, cidx >= 4, obase + (size_t)(cidx - 4) * 64 * 1024, wsl, S0, S1, S2, S3, Sb, lane, hi); }
            LBAR();
            { const int cidx = cidx_of(step + 1, dir); scan_step(lds + SBUF, cidx >= 4, obase + (size_t)(cidx - 4) * 64 * 1024, wsl, S0, S1, S2, S3, Sb, lane, hi); }
        }
    }
    __syncthreads();
#undef LBAR
#undef LD_ISSUE
#undef LD_WRITE
#undef U_ISSUE
}

__device__ __forceinline__ void phase5(const Args& a) {
    const int tid = threadIdx.x, lane = tid & 63, wave = tid >> 6;
    const int gw = blockIdx.x * 8 + wave, NGW = gridDim.x * 8;
    const bfu* OF = (const bfu*)(a.ws + WS_QKVG); const bfu* OB = OF + (size_t)NB * SEQ * 1024; bfu* Z = (bfu*)(a.ws + WS_Z);
    const float gw0 = a.in[11][2 * lane], gw1 = a.in[11][2 * lane + 1];
    for (int lr = gw; lr < NB * SEQ; lr += NGW) { const int b = lr / SEQ; const size_t zrow = (size_t)lr + CTXL * (b + 1);
        unsigned ff[8], gg[8], zq[8];
#pragma unroll
        for (int hh = 0; hh < 8; ++hh) { const int c0 = hh * 128 + 2 * lane; ff[hh] = *(const unsigned*)(OF + (size_t)lr * 1024 + c0); gg[hh] = *(const unsigned*)(OB + (size_t)lr * 1024 + c0); zq[hh] = *(const unsigned*)(Z + zrow * 2048 + c0); }
#pragma unroll
        for (int hh = 0; hh < 8; ++hh) { const int c0 = hh * 128 + 2 * lane;
            const unsigned f = ff[hh], g = gg[hh], zz = zq[hh]; unsigned* zp = (unsigned*)(Z + zrow * 2048 + c0);
            const float o0 = bflo(f) + bflo(g), o1 = bfhi(f) + bfhi(g);
            const float r = rsqrtf(wave_sum(o0 * o0 + o1 * o1) * (1.f / 128.f) + EPSF);
            *zp = cvtpk2(o0 * r * gw0 * siluf(bflo(zz)), o1 * r * gw1 * siluf(bfhi(zz))); }
    }
}
__device__ __forceinline__ void phase7(const Args& a, float* dst) {
    const int tid = threadIdx.x, lane = tid & 63, wave = tid >> 6;
    const int gw = blockIdx.x * 8 + wave, NGW = gridDim.x * 8; const float* fw = a.in[15];
    for (int row = gw; row < NB * SEQ; row += NGW) { v4f* p = (v4f*)(a.out + (size_t)row * DM); v4f v[8]; float ss = 0.f;
#pragma unroll
        for (int j = 0; j < 8; ++j) { v[j] = p[lane + 64 * j]; ss += (v[j].x * v[j].x + v[j].y * v[j].y) + (v[j].z * v[j].z + v[j].w * v[j].w); }
        const float rstd = rsqrtf(wave_sum(ss) * (1.f / DM) + EPSF);
#pragma unroll
        for (int j = 0; j < 8; ++j) { const v4f w = ((const v4f*)fw)[lane + 64 * j]; ((v4f*)(dst + (size_t)row * DM))[lane + 64 * j] = (v[j] * rstd) * w; }
    }
}

#define LAS __attribute__((address_space(3)))
#define XB_TMO      128
#define XB_XCNT(j)  (256  + 64 * (j))
#define XB_XSUB(j)  (1280 + 64 * (j))
#define XB_XGEN(j)  (2304 + 64 * (j))
#define XB_TOP      3328
#define XB_TOPGEN   3392
#define XCD_BAR_WORDS 3456
#define XB_SPIN_CAP (1u << 18)

__device__ __forceinline__ unsigned xb_ld(unsigned* p)              { return __hip_atomic_load(p, __ATOMIC_RELAXED, __HIP_MEMORY_SCOPE_AGENT); }
__device__ __forceinline__ unsigned xb_add(unsigned* p, unsigned v) { return __hip_atomic_fetch_add(p, v, __ATOMIC_RELAXED, __HIP_MEMORY_SCOPE_AGENT); }
__device__ __forceinline__ unsigned xb_xcc_id() { return (unsigned)__builtin_amdgcn_s_getreg((3 << 11) | 20) & 0xFu; }
#define XB_SPIN(cond, bar) do { unsigned _sp = 0; while (cond) { __builtin_amdgcn_s_sleep(1); \
    if ((++_sp & 255u) == 0u) { if (xb_ld(&(bar)[XB_TMO])) break; if (_sp > XB_SPIN_CAP) { atomicAdd(&(bar)[XB_TMO], 1u); break; } } } } while (0)

struct XcdBarrier {
    unsigned* bar; unsigned x;
    volatile LAS unsigned* st;
};

__device__ __forceinline__ XcdBarrier xcd_barrier_post(unsigned* bar, volatile LAS unsigned* st) {
    XcdBarrier b; b.bar = bar; b.x = xb_xcc_id(); b.st = st;
    if (threadIdx.x == 0) (void)xb_add(&bar[XB_XCNT(b.x)], 1u);
    return b;
}
__device__ __forceinline__ void xcd_barrier_complete(unsigned* bar, unsigned x, unsigned& nloc, unsigned& nx) {
    const unsigned G = gridDim.x * gridDim.y * gridDim.z;
    unsigned sum, cnt, mine, sp = 0u;
    for (;;) {
        sum = 0u; cnt = 0u; mine = 0u;
#pragma unroll
        for (unsigned j = 0; j < 16; ++j) { const unsigned c = xb_ld(&bar[XB_XCNT(j)]); sum += c; cnt += (c > 0u) ? 1u : 0u; mine = (j == x) ? c : mine; }
        if (sum == G) break;
        __builtin_amdgcn_s_sleep(1);
        if ((++sp & 255u) == 0u) { if (xb_ld(&bar[XB_TMO])) break; if (sp > XB_SPIN_CAP) { atomicAdd(&bar[XB_TMO], 1u); break; } }
    }
    nloc = mine > 0u ? mine : 1u; nx = cnt > 0u ? cnt : 1u;
}

__device__ __forceinline__ void xcd_barrier(const XcdBarrier& b) {
    asm volatile("s_waitcnt vmcnt(0)" ::: "memory");
    __syncthreads();
    if (threadIdx.x == 0) {
        unsigned* bar = b.bar;
        __builtin_amdgcn_s_waitcnt(0);
        unsigned nloc = b.st[0], nx = b.st[1];
        if (nloc == 0u) { xcd_barrier_complete(bar, b.x, nloc, nx); b.st[0] = nloc; b.st[1] = nx; }
        const unsigned old = xb_add(&bar[XB_XSUB(b.x)], 1u);
        const unsigned gen = old / nloc;
        if (old + 1u == (gen + 1u) * nloc) {
            __builtin_amdgcn_fence(__ATOMIC_RELEASE, "agent");
            asm volatile("s_waitcnt vmcnt(0)" ::: "memory");
            const unsigned og = xb_add(&bar[XB_TOP], 1u);
            const unsigned tg = og / nx;
            if (og + 1u == (tg + 1u) * nx) xb_add(&bar[XB_TOPGEN], 1u);
            else XB_SPIN(xb_ld(&bar[XB_TOPGEN]) == tg, bar);
            __builtin_amdgcn_fence(__ATOMIC_ACQUIRE, "agent");
            xb_add(&bar[XB_XGEN(b.x)], 1u);
            asm volatile("s_waitcnt vmcnt(0)" ::: "memory");
        } else {
            XB_SPIN(xb_ld(&bar[XB_XGEN(b.x)]) == gen, bar);
            __builtin_amdgcn_fence(__ATOMIC_ACQUIRE, "agent");
            asm volatile("s_waitcnt vmcnt(0)" ::: "memory");
        }
    }
    __syncthreads();
}

__global__ void __launch_bounds__(512, 2) mega_fwd(Args a) {
    extern __shared__ __attribute__((aligned(16))) unsigned char lds_[];
    char* lds = (char*)lds_;
    cg::grid_group grid = cg::this_grid();
    volatile LAS unsigned* xst = (volatile LAS unsigned*)(lds_ + LDS_BYTES - 32);
    if (threadIdx.x < 2) xst[threadIdx.x] = 0u;
    __syncthreads();
    XcdBarrier xbar; xbar.bar = (unsigned*)(a.ws + WS_BAR); xbar.x = 0; xbar.st = xst;
    const int lo = a.ph_lo, hi = a.ph_hi;
    unsigned char* ws = a.ws;
#ifndef MK_SKIP
#define MK_SKIP 0
#endif
#define IN(k) (!((MK_SKIP >> (k)) & 1) && lo <= (k) && (k) < hi)
#ifndef MK_DUPSYNC
#define MK_DUPSYNC 0
#endif
#define SEAM(k) do { if (IN(k) && IN((k) + 1)) { if ((k) == 0) { grid.sync(); xbar = xcd_barrier_post((unsigned*)(a.ws + WS_BAR), xst); } else { xcd_barrier(xbar); if (MK_DUPSYNC) { xcd_barrier(xbar); xcd_barrier(xbar); } } } } while (0)
#ifndef MK_DUP
#define MK_DUP 0
#endif
#define DUP(k) ((MK_DUP >> (k)) & 1)
#ifndef MK_TS_A
#define MK_TS_A -1
#define MK_TS_B -1
#endif
    unsigned long long ts_a = 0, ts_b = 0;
#define STAMP(k) do { if (MK_TS_A >= 0) { const unsigned long long t_ = __builtin_amdgcn_s_memrealtime(); if ((k) == MK_TS_A) ts_a = t_; if ((k) == MK_TS_B) ts_b = t_; } } while (0)
    STAMP(0);
    if (IN(0)) { phase0(a, lds); if (DUP(0)) { __syncthreads(); phase0(a, lds); } } SEAM(0); STAMP(1);
    if (IN(1)) { phase_wcopy(a, lds); phase1(a); if (DUP(1)) phase1(a); } SEAM(1); STAMP(2);
    for (int rep = 0; rep < 1 + DUP(2); ++rep) if (IN(2)) {
        pg8::Gemm g{(const pg8::bf16_t*)((const unsigned char*)a.out + OUT_H), (const pg8::bf16_t*)((const unsigned char*)a.out + OUT_WIN), MROWS, NPAD, DM}; InOrder S; S.so.init(MROWS, 13 * 256, (int)gridDim.x, (int)blockIdx.x); S.limit = 130 * 13; S.mode = 0;
        EpiIn E{(bfu*)(ws + WS_QKVG), (bfu*)(ws + WS_Z), (bfu*)(ws + WS_QKVA), (bfu*)(ws + WS_GATES)};
        pg8::gemm_phase<EpiIn, InOrder, true, true>((PG8_LAS unsigned char*)lds_, g, S, E);
    } SEAM(2); STAMP(3);
    if (IN(3)) {
        for (int rep = 0; rep < 1 + DUP(3); ++rep) {
            { unsigned raw[12][3]; float cw[5][3][2], gpre[4];
              if ((int)blockIdx.x < NB * GH * NCH) prep_load(a, (int)blockIdx.x, raw, cw, gpre);
              for (int it = blockIdx.x; it < NB * GH * NCH; it += gridDim.x) { const int nx = it + (int)gridDim.x; prep_item(a, lds, it, nx < NB * GH * NCH ? nx : -1, raw, cw, gpre); } }
            __syncthreads();
            { const int nit = (NB * GH * NCH - (int)blockIdx.x + (int)gridDim.x - 1) / (int)gridDim.x; const int wv = __builtin_amdgcn_readfirstlane((int)threadIdx.x >> 6);
              for (int p = wv; p < 2 * nit; p += 8) prep_part2(a, lds, (int)blockIdx.x + (p >> 1) * (int)gridDim.x, p & 1); }
            __syncthreads();
        }
    } SEAM(3); STAMP(4);
    if (IN(4)) {
        constexpr int NSCAN = 64, NUB = 130 * 14;
        const bool scanner = (int)blockIdx.x < NSCAN;
        if (scanner) { scan_item(a, lds, (int)blockIdx.x); if (DUP(4)) scan_item(a, lds, (int)blockIdx.x); }
#ifndef MK_SPLIT4
#define MK_SPLIT4 0
#endif
        if (MK_SPLIT4) { xcd_barrier(xbar); STAMP(9); }
        pg8::Gemm g{(const pg8::bf16_t*)((const unsigned char*)a.out + OUT_H), (const pg8::bf16_t*)((const unsigned char*)a.out + OUT_WIN), MROWS, NPAD, DM}; InOrder S; S.mode = 1;
#ifndef MK_SCAN_UNITS
#define MK_SCAN_UNITS 0
#endif
        if (MK_SPLIT4) { S.so.init(MROWS, 14 * 256, (int)gridDim.x, (int)blockIdx.x); S.limit = NUB; }
        else if (scanner) { S.so.init(MROWS, 14 * 256, 1 << 20, NUB - NSCAN + (int)blockIdx.x); S.limit = MK_SCAN_UNITS ? NUB : 0; }
        else { S.so.init(MROWS, 14 * 256, (int)gridDim.x - NSCAN, (int)blockIdx.x - NSCAN); S.limit = MK_SCAN_UNITS ? NUB - NSCAN : NUB; }
        EpiIn E{(bfu*)(ws + WS_QKVG), (bfu*)(ws + WS_Z), (bfu*)(ws + WS_QKVA), (bfu*)(ws + WS_GATES)};
        pg8::gemm_phase<EpiIn, InOrder, true, true>((PG8_LAS unsigned char*)lds_, g, S, E);
    } SEAM(4); STAMP(5);
    if (IN(5)) { phase3a(a); phase5(a); } SEAM(5); STAMP(6);
    if (IN(6)) {
        for (int u = blockIdx.x; u < 1024; u += gridDim.x) {
            __syncthreads();
            const int bkv = u >> 8, b = bkv >> 1, kvh = bkv & 1, rem = u & 255, g4 = rem >> 6, qb = rem & 63, head = kvh * 4 + g4;
            const bfu* QKVA = (const bfu*)(ws + WS_QKVA);
            const bfu* Qp = QKVA + (size_t)(b * TOK + CTXL + qb * 256) * 1536 + head * 128;
            const bfu* Kp = (const bfu*)(ws + WS_KC) + (size_t)(b * 2 + kvh) * TOK * 128; const bfu* Vp = (const bfu*)(ws + WS_VC) + (size_t)(b * 2 + kvh) * TOK * 128;
            bfu* Zp = (bfu*)(ws + WS_Z) + (size_t)(b * TOK + CTXL + qb * 256) * 2048 + 1024 + head * 128;
            if (DUP(6)) { att::attn_dense_body<att::bf16>((const att::bf16*)Qp, (const att::bf16*)Kp, (const att::bf16*)Vp, (bfu*)nullptr, TOK, lds); __syncthreads(); }
            att::attn_dense_body<att::bf16>((const att::bf16*)Qp, (const att::bf16*)Kp, (const att::bf16*)Vp, Zp, TOK, lds);
        }
    } SEAM(6); STAMP(7);
    if (IN(7)) {
        pg8::Gemm g{(const pg8::bf16_t*)(ws + WS_Z), (const pg8::bf16_t*)(ws + WS_WOUT), NB * SEQ, DM, DM};
        const int G_ = (int)gridDim.x, c_ = (int)blockIdx.x; OutOrderN S; S.G = G_; S.vc = (G_ % 8 == 0) ? (c_ % 8) * (G_ / 8) + c_ / 8 : c_;
        EpiOutNorm E{a.in[0], (const float*)(ws + WS_MOD), a.in[15], a.out, (float*)(ws + WS_XBUF), (unsigned*)(ws + WS_PCNT), lds + 131072};
        pg8::gemm_phase<EpiOutNorm, OutOrderN, true, true>((PG8_LAS unsigned char*)lds_, g, S, E);
    }
    if (MK_TS_A >= 0 && blockIdx.x == 0) { __syncthreads(); long long v = (long long)(ts_b - ts_a) / 100; v = v < 0 ? 0 : (v > 6000 ? 6000 : v);
        for (int i = threadIdx.x; i < (int)v; i += 512) a.out[i] += 0.25f; }
#undef IN
#undef SEAM
}

extern "C" void kernel_launch(void* const* d_in, const int* in_sizes, int n_in, void* d_out, int out_size, void* d_ws, size_t ws_size, hipStream_t stream) {
    static int grid = 0;
    if (grid == 0) {
        if (n_in != 16 || out_size != NB * SEQ * DM || ws_size < WS_END) { fprintf(stderr, "kernel_launch: unexpected shapes (n_in %d out %d ws %zu need %zu)\n", n_in, out_size, ws_size, (size_t)WS_END); grid = -1; return; }
        int dev = 0, cus = 0, per_cu = 0;
        hipGetDevice(&dev); hipDeviceGetAttribute(&cus, hipDeviceAttributeMultiprocessorCount, dev);
        if (hipFuncSetAttribute((const void*)mega_fwd, hipFuncAttributeMaxDynamicSharedMemorySize, LDS_BYTES) != hipSuccess) { fprintf(stderr, "kernel_launch: hipFuncSetAttribute failed\n"); grid = -1; return; }
        if (hipOccupancyMaxActiveBlocksPerMultiprocessor(&per_cu, (const void*)mega_fwd, 512, LDS_BYTES) != hipSuccess || per_cu < 1) { fprintf(stderr, "kernel_launch: occupancy query says %d\n", per_cu); per_cu = 1; }
        (void)hipGetLastError();
        grid = cus * per_cu;
        fprintf(stderr, "kernel_launch: grid %d (cus %d x %d)\n", grid, cus, per_cu);
    }
    if (grid < 0) return;
    Args a{};
    for (int i = 0; i < 16; ++i) a.in[i] = (const float*)d_in[i];
    a.out = (float*)d_out; a.ws = (unsigned char*)d_ws;
#if MK_COOP
    a.ph_lo = 0; a.ph_hi = NPHASE;
    void* args[] = {&a};
    hipError_t e = hipLaunchCooperativeKernel((const void*)mega_fwd, dim3(grid), dim3(512), args, LDS_BYTES, stream);
    if (e != hipSuccess) fprintf(stderr, "kernel_launch: cooperative launch failed: %s (grid %d)\n", hipGetErrorString(e), grid);
#else
    for (int p = 0; p < NPHASE; ++p) { a.ph_lo = p; a.ph_hi = p + 1; hipLaunchKernelGGL(mega_fwd, dim3(grid), dim3(512), LDS_BYTES, stream, a); }
#endif
}
```

```cpp
#include <hip/hip_runtime.h>
#include <hip/hip_bf16.h>
#include <hip/hip_cooperative_groups.h>
#include <cstdio>
#include <cstdint>
namespace cg = cooperative_groups;

#ifndef ATT_PROBE_K
#define ATT_PROBE_K 1.f
#endif
#ifndef MK_COOP
#define MK_COOP 1
#endif

constexpr int DM = 2048, NB = 2, SEQ = 16384, CTXL = 256, TOK = SEQ + CTXL, MROWS = NB * TOK;
constexpr int HD = 128, GH = 8, NCH = TOK / 64;
constexpr int INC = 6688, NPAD = 6912;
constexpr float EPSF = 1e-6f;
constexpr int NPHASE = 9;

constexpr size_t WS_CNT = 0, WS_MOD = 4096, WS_WOUT = 131072;
constexpr size_t WS_GATES = WS_WOUT + (size_t)DM * DM * 2;
constexpr size_t WS_Z = WS_GATES + (size_t)MROWS * 32 * 2;
constexpr size_t WS_QKVA = WS_Z + (size_t)MROWS * 2048 * 2;
constexpr size_t WS_QKVG = WS_QKVA + (size_t)MROWS * 1536 * 2;
constexpr size_t WS_FRAG = WS_QKVG + (size_t)MROWS * 3072 * 2;
constexpr size_t DIR_BYTES = 16384 + 8192 + 1024 + 16384;
constexpr size_t ITEM_BYTES = 32768 + 2 * DIR_BYTES;
constexpr size_t WS_KC = WS_FRAG + (size_t)NB * GH * NCH * ITEM_BYTES;
constexpr size_t WS_VC = WS_KC + (size_t)NB * 2 * TOK * 128 * 2;
constexpr size_t WS_BAR = WS_VC + (size_t)NB * 2 * TOK * 128 * 2;
constexpr size_t WS_XBUF = WS_BAR + 16384;
constexpr size_t WS_PCNT = WS_XBUF + (size_t)NB * SEQ * 8 * 4;
constexpr size_t WS_END = WS_PCNT + 128 * 256;
constexpr size_t OUT_H = 0, OUT_WIN = (size_t)MROWS * DM * 2;
static_assert(OUT_WIN + (size_t)NPAD * DM * 2 <= (size_t)NB * SEQ * DM * 4, "H + WinT fit in d_out");
static_assert((size_t)2 * NB * SEQ * 1024 * 2 <= (size_t)MROWS * 3072 * 2, "O_gdn fits over QKVG");

constexpr int LDS_BYTES = 151552;

typedef unsigned short bfu;
typedef float f32x16 __attribute__((ext_vector_type(16)));
typedef unsigned u32x2 __attribute__((ext_vector_type(2)));
__device__ __forceinline__ float bf2f(unsigned short u) { return __uint_as_float(((unsigned)u) << 16); }
__device__ __forceinline__ float bflo(unsigned w) { return __uint_as_float(w << 16); }
__device__ __forceinline__ float bfhi(unsigned w) { return __uint_as_float(w & 0xffff0000u); }
__device__ __forceinline__ float wave_sum(float v) {
#pragma unroll
    for (int o = 1; o < 64; o <<= 1) v += __shfl_xor(v, o);
    return v;
}
__device__ __forceinline__ float siluf(float x) { return x * __builtin_amdgcn_rcpf(1.f + __expf(-x)); }

namespace pg8 {
#define PG8_LAS __attribute__((address_space(3)))
typedef unsigned short bf16_t;
typedef short bf16x8 __attribute__((ext_vector_type(8)));
typedef float f32x4 __attribute__((ext_vector_type(4)));
typedef unsigned u32x4 __attribute__((ext_vector_type(4)));
constexpr int BM = 256, BK = 64, HALF = 128, HTB = HALF * BK * 2  , STAGE_BYTES = 8 * HTB, NXCD = 8, WGM = 8;

__host__ __device__ __forceinline__ int lds_byte(int r, int c) { const int st = (r >> 4) * 2 + (c >> 5), rr = r & 15, cc = c & 31, ob = rr * 64 + cc * 2; return st * 1024 + (ob ^ (((ob >> 9) & 1) << 5)); }
__host__ __device__ __forceinline__ void stage_rc(int b, int& R, int& C) { const int st = b / 1024, sb = b % 1024, swz = sb ^ (((sb >> 9) & 1) << 5); R = (st >> 1) * 16 + swz / 64; C = (st & 1) * 32 + (swz % 64) / 2; }
__host__ __device__ __forceinline__ int perm32(int rho) { const int n = rho >> 4, i = rho & 15; return 8 * (i >> 2) + 4 * n + (i & 3); }

struct Unit { int pm, pn; };
struct Gemm { const bf16_t* A; const bf16_t* Bt; int M, N, K; };

struct StaticOrder {
    int nM, nN, nwg, G, c;
    __host__ __device__ void init(int M, int N, int G_, int c_) { nM = M / BM; nN = N / BM; nwg = nM * nN; G = G_; c = c_; }
    __host__ __device__ bool next(int i, Unit& u) const {
        const long L = (long)i * G + c; if (L >= nwg) return false;
        int wgid = (int)L; { const int q = nwg / NXCD, r = nwg % NXCD, xcd = wgid % NXCD, off = wgid / NXCD; wgid = (xcd < r ? xcd * (q + 1) : r * (q + 1) + (xcd - r) * q) + off; }
        const int nig = WGM * nN, gid = wgid / nig, fm = gid * WGM, gsz = (nM - fm) < WGM ? (nM - fm) : WGM;
        u.pm = fm + ((wgid % nig) % gsz); u.pn = (wgid % nig) / gsz; return true;
    }
    __device__ __forceinline__ void a_ready(const Unit&) const {}
    __device__ __forceinline__ void done(const Unit&) const {}
};

__device__ __forceinline__ unsigned cvt_pk_bf16(float lo, float hi) { unsigned r; asm volatile("v_cvt_pk_bf16_f32 %0, %1, %2" : "=v"(r) : "v"(lo), "v"(hi)); return r; }
template <class Epi, class Sched, bool ALIGN_EPI = false, bool SP2 = false>
__device__ __forceinline__ void gemm_phase(PG8_LAS unsigned char* lds, const Gemm g, const Sched& S, const Epi& E) {
    const int tid = threadIdx.x, wid = __builtin_amdgcn_readfirstlane(tid >> 6), lane = tid & 63, wr = wid >> 2, wc = wid & 3, fr = lane & 15, fq = lane >> 4;
    const int K = g.K, nt = K / BK;
    unsigned voffA[2], voffB[2];
#pragma unroll
    for (int i = 0; i < 2; ++i) { int R, C; stage_rc(tid * 16 + i * 8192, R, C); const int Rb = Epi::PERM ? ((R & ~31) + perm32(R & 31)) : R;
        voffA[i] = (unsigned)(R * K + C) * 2u; voffB[i] = (unsigned)(Rb * K + C) * 2u; }
    const size_t kstep = (size_t)(BK * 2);
    const size_t hstep = (size_t)HALF * K * 2;
    const size_t tstep = 2 * hstep;
    const unsigned ldsw = (unsigned)wid * 1024u;
    const int aoff = lds_byte(wr * 64 + fr, fq * 8), boff = lds_byte(wc * 32 + fr, fq * 8);
#define PG8_SA(b, h) (((b) * 2 + (h)) * HTB)
#define PG8_SB(b, h) ((4 + (b) * 2 + (h)) * HTB)
#define PG8_STAGE(bufoff, gbase, voff) do { _Pragma("unroll") for (int _i = 0; _i < 2; ++_i) \
        __builtin_amdgcn_global_load_lds((const unsigned*)((const char*)(gbase) + (voff)[_i]), (PG8_LAS unsigned*)(lds + (bufoff) + ldsw + _i * 8192), 16, 0, 0); } while (0)
#define PG8_LDA(dst, b, h) do { _Pragma("unroll") for (int m = 0; m < 4; ++m) _Pragma("unroll") for (int k = 0; k < 2; ++k) dst[m][k] = *(const PG8_LAS bf16x8*)(lds + PG8_SA(b, h) + aoff + m * 2048 + k * 1024); } while (0)
#define PG8_LDB(dst, b, h) do { _Pragma("unroll") for (int n = 0; n < 2; ++n) _Pragma("unroll") for (int k = 0; k < 2; ++k) dst[n][k] = *(const PG8_LAS bf16x8*)(lds + PG8_SB(b, h) + boff + n * 2048 + k * 1024); } while (0)
#define PG8_MMA(ai, bj, At, Bt) do { __builtin_amdgcn_s_setprio(1); _Pragma("unroll") for (int m = 0; m < 4; ++m) _Pragma("unroll") for (int n = 0; n < 2; ++n) _Pragma("unroll") for (int k = 0; k < 2; ++k) \
        acc[ai][bj][m][n] = __builtin_amdgcn_mfma_f32_16x16x32_bf16(Bt[n][k], At[m][k], acc[ai][bj][m][n], 0, 0, 0); __builtin_amdgcn_s_setprio(0); } while (0)
#define PG8_WAIT_V(n) asm volatile("s_waitcnt vmcnt(" #n ")" ::: "memory")
#define PG8_WAIT_L(n) asm volatile("s_waitcnt lgkmcnt(" #n ")" ::: "memory")
#define PG8_BAR __builtin_amdgcn_s_barrier()
#define PG8_SCHED __builtin_amdgcn_sched_barrier(0)
    Unit cur, nxt; int ui = 0;
    if (!S.next(0, cur)) return;
    f32x4 acc[2][2][4][2];
#pragma unroll
    for (int a = 0; a < 2; ++a)
#pragma unroll
        for (int b = 0; b < 2; ++b)
#pragma unroll
            for (int m = 0; m < 4; ++m)
#pragma unroll
                for (int n = 0; n < 2; ++n) acc[a][b][m][n] = (f32x4){0.f, 0.f, 0.f, 0.f};
    bf16x8 At[4][2], B0[2][2], B1[2][2];
    const char* cA = (const char*)g.A + (size_t)cur.pm * tstep; const char* cB = (const char*)g.Bt + (size_t)cur.pn * tstep;
    S.a_ready(cur);
    if constexpr (SP2) {
        PG8_STAGE(PG8_SB(0, 0), cB, voffB); PG8_STAGE(PG8_SB(0, 1), cB + hstep, voffB); PG8_STAGE(PG8_SA(0, 0), cA, voffA); PG8_STAGE(PG8_SA(0, 1), cA + hstep, voffA);
        if (wr == 1) PG8_BAR;
        PG8_WAIT_V(2); PG8_BAR;
        PG8_STAGE(PG8_SB(1, 0), cB + kstep, voffB); PG8_STAGE(PG8_SA(1, 0), cA + kstep, voffA); PG8_STAGE(PG8_SB(1, 1), cB + hstep + kstep, voffB);
        PG8_WAIT_V(6); PG8_BAR;
    } else {
        PG8_STAGE(PG8_SB(0, 0), cB, voffB); PG8_STAGE(PG8_SA(0, 0), cA, voffA); PG8_STAGE(PG8_SB(0, 1), cB + hstep, voffB); PG8_STAGE(PG8_SA(0, 1), cA + hstep, voffA);
        if (wr == 1) PG8_BAR;
        PG8_WAIT_V(4); PG8_BAR;
        PG8_STAGE(PG8_SB(1, 0), cB + kstep, voffB); PG8_STAGE(PG8_SA(1, 0), cA + kstep, voffA); PG8_STAGE(PG8_SB(1, 1), cB + hstep + kstep, voffB);
        PG8_WAIT_V(6); PG8_BAR;
    }
    for (;;) {
        const bool has_next = S.next(ui + 1, nxt);
        const char* nA = has_next ? (const char*)g.A + (size_t)nxt.pm * tstep : cA; const char* nB = has_next ? (const char*)g.Bt + (size_t)nxt.pn * tstep : cB;
        for (int t = 0; t < nt; t += 2) {
            const bool last = (t == nt - 2);
            const char* a1 = cA + (size_t)(t + 1) * kstep;
            const char* a2 = last ? nA : cA + (size_t)(t + 2) * kstep; const char* b2 = last ? nB : cB + (size_t)(t + 2) * kstep;
            const char* a3 = a2 + kstep; const char* b3 = b2 + kstep;
            if (last && has_next) S.a_ready(nxt);
            if constexpr (SP2) {
            PG8_LDB(B0, 0, 0); PG8_LDB(B1, 0, 1); PG8_SCHED; PG8_LDA(At, 0, 0); PG8_STAGE(PG8_SA(1, 1), a1 + hstep, voffA);
            PG8_WAIT_V(8); PG8_WAIT_L(0); PG8_BAR; PG8_MMA(0, 0, At, B0); PG8_MMA(0, 1, At, B1); PG8_BAR; PG8_SCHED;
            PG8_LDA(At, 0, 1); PG8_STAGE(PG8_SB(0, 0), b2, voffB); PG8_STAGE(PG8_SB(0, 1), b2 + hstep, voffB); PG8_STAGE(PG8_SA(0, 0), a2, voffA);
            PG8_WAIT_V(8); PG8_WAIT_L(0); PG8_BAR; PG8_MMA(1, 0, At, B0); PG8_MMA(1, 1, At, B1); PG8_BAR; PG8_SCHED;
            PG8_LDB(B0, 1, 0); PG8_LDB(B1, 1, 1); PG8_SCHED; PG8_LDA(At, 1, 0); PG8_STAGE(PG8_SA(0, 1), a2 + hstep, voffA);
            PG8_WAIT_V(8); PG8_WAIT_L(0); PG8_BAR; PG8_MMA(0, 0, At, B0); PG8_MMA(0, 1, At, B1); PG8_BAR; PG8_SCHED;
            PG8_LDA(At, 1, 1); PG8_STAGE(PG8_SB(1, 0), b3, voffB); PG8_STAGE(PG8_SB(1, 1), b3 + hstep, voffB); PG8_STAGE(PG8_SA(1, 0), a3, voffA);
            PG8_WAIT_V(8); PG8_WAIT_L(0); PG8_BAR; PG8_MMA(1, 0, At, B0); PG8_MMA(1, 1, At, B1); PG8_BAR; PG8_SCHED;
            } else {
            PG8_LDB(B0, 0, 0); PG8_SCHED; PG8_LDA(At, 0, 0); PG8_STAGE(PG8_SA(1, 1), a1 + hstep, voffA);
            PG8_WAIT_L(8); PG8_BAR; PG8_WAIT_L(0); PG8_MMA(0, 0, At, B0); PG8_BAR; PG8_SCHED;
            PG8_LDB(B1, 0, 1); PG8_STAGE(PG8_SB(0, 0), b2, voffB);
            PG8_BAR; PG8_WAIT_L(0); PG8_MMA(0, 1, At, B1); PG8_BAR;
            PG8_LDA(At, 0, 1); PG8_STAGE(PG8_SA(0, 0), a2, voffA);
            PG8_BAR; PG8_WAIT_L(0); PG8_MMA(1, 0, At, B0); PG8_BAR; PG8_SCHED;
            PG8_STAGE(PG8_SB(0, 1), b2 + hstep, voffB);
            PG8_WAIT_V(6); PG8_BAR; PG8_MMA(1, 1, At, B1); PG8_BAR;
            PG8_LDB(B0, 1, 0); PG8_SCHED; PG8_LDA(At, 1, 0); PG8_STAGE(PG8_SA(0, 1), a2 + hstep, voffA);
            PG8_WAIT_L(8); PG8_BAR; PG8_WAIT_L(0); PG8_MMA(0, 0, At, B0); PG8_BAR; PG8_SCHED;
            PG8_LDB(B1, 1, 1); PG8_STAGE(PG8_SB(1, 0), b3, voffB);
            PG8_BAR; PG8_WAIT_L(0); PG8_MMA(0, 1, At, B1); PG8_BAR;
            PG8_LDA(At, 1, 1); PG8_STAGE(PG8_SA(1, 0), a3, voffA);
            PG8_BAR; PG8_WAIT_L(0); PG8_MMA(1, 0, At, B0); PG8_BAR; PG8_SCHED;
            PG8_STAGE(PG8_SB(1, 1), b3 + hstep, voffB);
            PG8_WAIT_V(6); PG8_BAR; PG8_MMA(1, 1, At, B1); PG8_BAR;
            }
        }
        if constexpr (ALIGN_EPI) { if (wr == 0) PG8_BAR; }
        if constexpr (!Epi::AFTER_DRAIN) { E(acc, cur, wr, wc, fr, fq); S.done(cur); }
        if (!has_next) break;
#pragma unroll
        for (int a = 0; a < 2; ++a)
#pragma unroll
            for (int b = 0; b < 2; ++b)
#pragma unroll
                for (int m = 0; m < 4; ++m)
#pragma unroll
                    for (int n = 0; n < 2; ++n) acc[a][b][m][n] = (f32x4){0.f, 0.f, 0.f, 0.f};
        cur = nxt; cA = nA; cB = nB; ++ui;
        if constexpr (ALIGN_EPI) { if (wr == 1) PG8_BAR; }
    }
    PG8_WAIT_V(0);
    if constexpr (!ALIGN_EPI) { if (wr == 0) PG8_BAR; }
    PG8_BAR;
    if constexpr (Epi::AFTER_DRAIN) { E.fused(acc, cur, wr, wc, fr, fq, lds, wid, lane); S.done(cur); }
#undef PG8_SA
#undef PG8_SB
#undef PG8_STAGE
#undef PG8_LDA
#undef PG8_LDB
#undef PG8_MMA
#undef PG8_WAIT_V
#undef PG8_WAIT_L
#undef PG8_BAR
#undef PG8_SCHED
}
}

namespace att {
using bf16 = __hip_bfloat16;
constexpr int D = 128, NW = 8, QBLK = 32, KVBLK = 64;
constexpr float SCALE = 0.088388347648318440f;
constexpr float THR = 8.f;
constexpr int SDEPTH = 2;
constexpr int LDQ = 1536, LDK = 128, LDO = 2048;
constexpr size_t SHM_V = KVBLK * D * 2, SHM_K = KVBLK * D * 2, SHM_ATTN = 2 * SHM_V + 2 * SHM_K + NW * 64 * 4;
using bf16x8 = __attribute__((ext_vector_type(8))) short;
using s16x4  = __attribute__((ext_vector_type(4))) short;
using f32x16 = __attribute__((ext_vector_type(16))) float;
using f32x8  = __attribute__((ext_vector_type(8))) float;
using u32x4  = __attribute__((ext_vector_type(4))) unsigned;
#define KSWZ(row, colB) ((row) * 256 + ((colB) ^ (((row) & 7) << 4)))
#define SBAR() __builtin_amdgcn_sched_barrier(0)
__device__ __forceinline__ int crow(int r, int hi) { return (r & 3) + 8 * (r >> 2) + 4 * hi; }
__device__ __forceinline__ unsigned cvtpk(float lo, float hi) {
  unsigned r; asm volatile("v_cvt_pk_bf16_f32 %0, %1, %2" : "=v"(r) : "v"(lo), "v"(hi)); return r;
}
template <typename TIn> struct Stage;
template <> struct Stage<bf16>  { using T = bf16x8;
  __device__ static __forceinline__ T ld8(const bf16* p) { return *reinterpret_cast<const bf16x8*>(p); }
  __device__ static __forceinline__ bf16x8 tobf(T x) { return x; } };
template <> struct Stage<float> { using T = f32x8;
  __device__ static __forceinline__ T ld8(const float* p) { return *reinterpret_cast<const f32x8*>(p); }
  __device__ static __forceinline__ bf16x8 tobf(T x) {
    u32x4 w = {cvtpk(x[0], x[1]), cvtpk(x[2], x[3]), cvtpk(x[4], x[5]), cvtpk(x[6], x[7])}; return *reinterpret_cast<bf16x8*>(&w); } };

__device__ __forceinline__ void partialSM(f32x16& p0, f32x16& p1, float& m_reg, float& mn, float& alpha) {
  constexpr float C = SCALE * 1.4426950408889634f;
  float pmax = p0[0]; for (int r = 1; r < 16; ++r) pmax = fmaxf(pmax, p0[r]); for (int r = 0; r < 16; ++r) pmax = fmaxf(pmax, p1[r]);
  { auto rr = __builtin_amdgcn_permlane32_swap(__float_as_uint(pmax), __float_as_uint(pmax), false, false);
    pmax = fmaxf(__uint_as_float(rr[0]), __uint_as_float(rr[1])); }
  if (__builtin_expect(__all(pmax - m_reg <= THR / SCALE), 1)) { mn = m_reg; alpha = 1.f; }
  else { mn = fmaxf(m_reg, pmax); alpha = __builtin_amdgcn_exp2f((m_reg - mn) * C); m_reg = mn; }
  float mnC = -mn * C;
  for (int r = 0; r < 16; ++r) p0[r] = fmaf(p0[r], C, mnC); for (int r = 0; r < 16; ++r) p1[r] = fmaf(p1[r], C, mnC);
  for (int r = 0; r < 16; ++r) p0[r] = __builtin_amdgcn_exp2f(p0[r]);
}
__device__ __forceinline__ void finishSM(f32x16& p0, f32x16& p1, float alpha, float& l_reg, bf16x8& pa0, bf16x8& pa1, bf16x8& pa2, bf16x8& pa3) {
  for (int r = 0; r < 16; ++r) p1[r] = __builtin_amdgcn_exp2f(p1[r]);
  float ps = 0; for (int r = 0; r < 16; ++r) ps += p0[r]; for (int r = 0; r < 16; ++r) ps += p1[r];
  { auto rr = __builtin_amdgcn_permlane32_swap(__float_as_uint(ps), __float_as_uint(ps), false, false);
    ps = __uint_as_float(rr[0]) + __uint_as_float(rr[1]); }
  l_reg = l_reg * alpha + ps;
#define PK4(P, BASE, OUT) do { unsigned a0 = cvtpk(P[BASE + 0], P[BASE + 1]), a1 = cvtpk(P[BASE + 2], P[BASE + 3]);   \
    unsigned b0 = cvtpk(P[BASE + 4], P[BASE + 5]), b1 = cvtpk(P[BASE + 6], P[BASE + 7]);                              \
    auto r0 = __builtin_amdgcn_permlane32_swap(a0, b0, false, false); auto r1 = __builtin_amdgcn_permlane32_swap(a1, b1, false, false); \
    u32x4 w = {r0[0], r1[0], r0[1], r1[1]}; OUT = *reinterpret_cast<bf16x8*>(&w); } while (0)
  PK4(p0, 0, pa0); PK4(p0, 8, pa1); PK4(p1, 0, pa2); PK4(p1, 8, pa3);
#undef PK4
}
__device__ __forceinline__ void qkt(f32x16& p0, f32x16& p1, const bf16* Ks, const bf16x8* qr, int r32, int hi) {
  p0 = f32x16{}; p1 = f32x16{};
  for (int d0 = 0; d0 < 8; ++d0) { int cb = (d0 * 16 + hi * 8) * 2;
    bf16x8 b0 = *reinterpret_cast<const bf16x8*>((const char*)Ks + KSWZ(r32, cb));
    bf16x8 b1 = *reinterpret_cast<const bf16x8*>((const char*)Ks + KSWZ(32 + r32, cb));
    p0 = __builtin_amdgcn_mfma_f32_32x32x16_bf16(b0, qr[d0], p0, 0, 0, 0);
    p1 = __builtin_amdgcn_mfma_f32_32x32x16_bf16(b1, qr[d0], p1, 0, 0, 0); }
}
__device__ __forceinline__ int v_st(int k, int c) { const int kk = (k & ~0xC) | ((k & 4) << 1) | ((k & 8) >> 1); return ((kk >> 3) * 4 + (c >> 5)) * 512 + ((kk & 7) * 32 + (c & 31)) * 2; }
__device__ __forceinline__ int v_rd_base(int lane) { return ((lane & 3) << 3) | (((lane >> 2) & 3) << 6) | (((lane >> 4) & 1) << 5) | (((lane >> 5) & 1) << 8); }
constexpr int v_rd_off(int d0, int ks, int half) { return d0 * 512 + ks * 4096 + half * 2048; }
template <int OFF> __device__ __forceinline__ s16x4 tr_read(int vb) {
  s16x4 r; asm volatile("ds_read_b64_tr_b16 %0, %1 offset:%2" : "=&v"(r) : "v"(vb), "i"(OFF) : "memory"); return r;
}
template <int D0> __device__ __forceinline__ void pv_one(f32x16& od, int vb, bf16x8 pa0, bf16x8 pa1, bf16x8 pa2, bf16x8 pa3) {
  const s16x4 l0 = tr_read<v_rd_off(D0, 0, 0)>(vb), h0 = tr_read<v_rd_off(D0, 0, 1)>(vb), l1 = tr_read<v_rd_off(D0, 1, 0)>(vb), h1 = tr_read<v_rd_off(D0, 1, 1)>(vb);
  const s16x4 l2 = tr_read<v_rd_off(D0, 2, 0)>(vb), h2 = tr_read<v_rd_off(D0, 2, 1)>(vb), l3 = tr_read<v_rd_off(D0, 3, 0)>(vb), h3 = tr_read<v_rd_off(D0, 3, 1)>(vb);
  asm volatile("s_waitcnt lgkmcnt(0)" ::: "memory"); SBAR();
#define PK(L, H) (bf16x8){L[0], L[1], L[2], L[3], H[0], H[1], H[2], H[3]}
  od = __builtin_amdgcn_mfma_f32_32x32x16_bf16(pa0, PK(l0, h0), od, 0, 0, 0);
  od = __builtin_amdgcn_mfma_f32_32x32x16_bf16(pa1, PK(l1, h1), od, 0, 0, 0);
  od = __builtin_amdgcn_mfma_f32_32x32x16_bf16(pa2, PK(l2, h2), od, 0, 0, 0);
  od = __builtin_amdgcn_mfma_f32_32x32x16_bf16(pa3, PK(l3, h3), od, 0, 0, 0);
#undef PK
}
__device__ __forceinline__ void pv_d0(f32x16* o, int vb, bf16x8 pa0, bf16x8 pa1, bf16x8 pa2, bf16x8 pa3) {
  pv_one<0>(o[0], vb, pa0, pa1, pa2, pa3); pv_one<1>(o[1], vb, pa0, pa1, pa2, pa3); pv_one<2>(o[2], vb, pa0, pa1, pa2, pa3); pv_one<3>(o[3], vb, pa0, pa1, pa2, pa3);
}

template <typename TQ>
__device__ __forceinline__ void attn_dense_body(const TQ* __restrict__ Qb, const bf16* __restrict__ Kh, const bf16* __restrict__ Vh,
                                                unsigned short* Ob, int seq, char* lds) {
  using St = Stage<bf16>; using SQ = Stage<TQ>;
  int tid_o = threadIdx.x; asm volatile("" : "+v"(tid_o));
  const int tid = tid_o, wid = tid >> 6, lane = tid & 63, r32 = lane & 31, hi = lane >> 5;
  bf16* V_lds = (bf16*)lds; bf16* K_lds = (bf16*)(lds + 2 * SHM_V);
  float* ws = (float*)(lds + 2 * SHM_V + 2 * SHM_K) + wid * 64; float* li_l = ws; float* al_l = ws + 32;
  float m_reg = -1e30f, l_reg = 0; f32x16 o[4] = {}; bf16x8 qr[8];
  const TQ* Qw = Qb + (long)(wid * QBLK + r32) * LDQ + hi * 8;
#pragma unroll
  for (int d0 = 0; d0 < 8; ++d0) qr[d0] = SQ::tobf(SQ::ld8(Qw + d0 * 16));
  const int sr = tid >> 4, sc = (tid & 15) * 8, vst0 = v_st(sr, sc), vst1 = v_st(32 + sr, sc);
  const int vb0 = (int)(uintptr_t)V_lds + v_rd_base(lane);
  struct { typename St::T vs0, vs1, ks0, ks1; } sr_[SDEPTH];
#define SLOAD(i, k0) do { sr_[i].vs0 = St::ld8(&Vh[(long)((k0) + sr) * LDK + sc]); sr_[i].vs1 = St::ld8(&Vh[(long)((k0) + 32 + sr) * LDK + sc]); \
    sr_[i].ks0 = St::ld8(&Kh[(long)((k0) + sr) * LDK + sc]); sr_[i].ks1 = St::ld8(&Kh[(long)((k0) + 32 + sr) * LDK + sc]); } while (0)
#define SWRITE(b, i) do { *(bf16x8*)((char*)V_lds + (b) * SHM_V + vst0) = St::tobf(sr_[i].vs0);          \
    *(bf16x8*)((char*)V_lds + (b) * SHM_V + vst1) = St::tobf(sr_[i].vs1); int kc = sc * 2;               \
    *(bf16x8*)((char*)K_lds + (b) * SHM_K + KSWZ(sr, kc)) = St::tobf(sr_[i].ks0);                       \
    *(bf16x8*)((char*)K_lds + (b) * SHM_K + KSWZ(32 + sr, kc)) = St::tobf(sr_[i].ks1); } while (0)
#define SWAIT() do { if constexpr (SDEPTH == 2) asm volatile("s_waitcnt vmcnt(4)" ::: "memory"); else asm volatile("s_waitcnt vmcnt(0)" ::: "memory"); } while (0)
#define RESC(a) do { if (__any((a) < 1.f)) { if (hi == 0) al_l[r32] = (a); asm volatile("s_waitcnt lgkmcnt(0)" ::: "memory"); \
    for (int d = 0; d < 4; ++d) for (int r = 0; r < 16; ++r) o[d][r] *= al_l[crow(r, hi)]; } } while (0)
  f32x16 pA0, pA1, pB0, pB1; float mnA, mnB, alA, alB; bf16x8 pa0, pa1, pa2, pa3; const int NT = seq / KVBLK;
  constexpr int SE = 0, SO = SDEPTH - 1;
  SLOAD(SE, 0); asm volatile("s_waitcnt vmcnt(0)" ::: "memory"); SWRITE(0, SE); __syncthreads();
  qkt(pA0, pA1, K_lds, qr, r32, hi); partialSM(pA0, pA1, m_reg, mnA, alA);
  SLOAD(SO, KVBLK); if constexpr (SDEPTH == 2) { if (2 < NT) SLOAD(SE, 2 * KVBLK); }
  SWAIT(); SWRITE(1, SO); __syncthreads();
  for (int j = 1; j + 1 < NT; j += 2) {
    SBAR(); qkt(pB0, pB1, (bf16*)((char*)K_lds + SHM_K), qr, r32, hi);
    finishSM(pA0, pA1, alA, l_reg, pa0, pa1, pa2, pa3); SBAR();
    SLOAD(SO, (j + SDEPTH) * KVBLK); SBAR();
    pv_d0(o, vb0, pa0, pa1, pa2, pa3); partialSM(pB0, pB1, m_reg, mnB, alB);
    __syncthreads(); SWAIT(); SWRITE(0, SE);
    RESC(alB); __syncthreads();
    SBAR(); qkt(pA0, pA1, K_lds, qr, r32, hi);
    finishSM(pB0, pB1, alB, l_reg, pa0, pa1, pa2, pa3); SBAR();
    if (SDEPTH == 1 || j + 3 < NT) SLOAD(SE, (j + 1 + SDEPTH) * KVBLK); SBAR();
    pv_d0(o, vb0 + (int)SHM_V, pa0, pa1, pa2, pa3); partialSM(pA0, pA1, m_reg, mnA, alA);
    __syncthreads(); SWAIT(); SWRITE(1, SO);
    RESC(alA); __syncthreads();
  }
  SBAR(); qkt(pB0, pB1, (bf16*)((char*)K_lds + SHM_K), qr, r32, hi);
  finishSM(pA0, pA1, alA, l_reg, pa0, pa1, pa2, pa3); SBAR();
  pv_d0(o, vb0, pa0, pa1, pa2, pa3); partialSM(pB0, pB1, m_reg, mnB, alB);
  __syncthreads(); RESC(alB);
  finishSM(pB0, pB1, alB, l_reg, pa0, pa1, pa2, pa3); SBAR();
  pv_d0(o, vb0 + (int)SHM_V, pa0, pa1, pa2, pa3);
  if (hi == 0) li_l[r32] = l_reg; asm volatile("s_waitcnt lgkmcnt(0)" ::: "memory");
  float rli[16];
#pragma unroll
  for (int r = 0; r < 16; ++r) rli[r] = __builtin_amdgcn_rcpf(li_l[crow(r, hi)]);
  unsigned short* Ow = Ob + (long)(wid * QBLK) * LDO;
  if (Ob) {
    unsigned short zr[16][4];
#pragma unroll
    for (int r = 0; r < 16; ++r) { const int orow = crow(r, hi);
#pragma unroll
      for (int d0 = 0; d0 < 4; ++d0) zr[r][d0] = Ow[(long)orow * LDO + d0 * 32 + r32]; }
#pragma unroll
    for (int r = 0; r < 16; ++r) { const int orow = crow(r, hi);
#pragma unroll
      for (int d0 = 0; d0 < 4; ++d0) { const float z = __uint_as_float(((unsigned)zr[r][d0]) << 16);
        const float v = ATT_PROBE_K * o[d0][r] * rli[r] * z / (1.f + __expf(-z)); Ow[(long)orow * LDO + d0 * 32 + r32] = (unsigned short)(cvtpk(v, 0.f) & 0xffffu); } }
  }
#undef SLOAD
#undef SWRITE
#undef SWAIT
#undef RESC
}

}

typedef short v8s __attribute__((ext_vector_type(8)));
typedef float v4f __attribute__((ext_vector_type(4)));
typedef unsigned v4u __attribute__((ext_vector_type(4)));
#define MFMA32(a, b, c) __builtin_amdgcn_mfma_f32_32x32x16_bf16((a), (b), (c), 0, 0, 0)
typedef float f32x2_t __attribute__((ext_vector_type(2))); typedef __bf16 bf16x2_t __attribute__((ext_vector_type(2)));
__device__ __forceinline__ unsigned cvtpk2(float lo, float hi) { f32x2_t v = {lo, hi}; bf16x2_t b = __builtin_convertvector(v, bf16x2_t); return __builtin_bit_cast(unsigned, b); }
__device__ __forceinline__ int crow_(int r, int hi) { return (r & 3) + 8 * (r >> 2) + 4 * hi; }
template <int BASE> __device__ __forceinline__ v8s pk4(const f32x16& P) {
    const unsigned a0 = cvtpk2(P[BASE + 0], P[BASE + 1]), a1 = cvtpk2(P[BASE + 2], P[BASE + 3]);
    const unsigned b0 = cvtpk2(P[BASE + 4], P[BASE + 5]), b1 = cvtpk2(P[BASE + 6], P[BASE + 7]);
    auto r0 = __builtin_amdgcn_permlane32_swap(a0, b0, false, false); auto r1 = __builtin_amdgcn_permlane32_swap(a1, b1, false, false);
    v4u w = {r0[0], r1[0], r0[1], r1[1]}; return __builtin_bit_cast(v8s, w);
}

struct Args { const float* in[16]; float* out; unsigned char* ws; int ph_lo, ph_hi; };

__device__ __forceinline__ void transpose_item(const float* __restrict__ W, int N, bfu* __restrict__ WT, int K, int k0, int n0, int dn0, float* scr, int lane) {
#pragma unroll 8
    for (int i = 0; i < 32; ++i) { const int kk = 2 * i + (lane >> 5); scr[kk * 33 + (lane & 31)] = W[(size_t)(k0 + kk) * N + n0 + (lane & 31)]; }
    asm volatile("s_waitcnt lgkmcnt(0)" ::: "memory");
    const int c = lane & 7;
#pragma unroll
    for (int j = 0; j < 4; ++j) { const int n = (lane >> 3) + 8 * j; const float* s = scr + (8 * c) * 33 + n;
        v4u o; o.x = cvtpk2(s[0 * 33], s[1 * 33]); o.y = cvtpk2(s[2 * 33], s[3 * 33]); o.z = cvtpk2(s[4 * 33], s[5 * 33]); o.w = cvtpk2(s[6 * 33], s[7 * 33]);
        *(v4u*)(WT + (size_t)(dn0 + n) * K + k0 + 8 * c) = o; }
    asm volatile("s_waitcnt lgkmcnt(0)" ::: "memory");
}
__device__ __forceinline__ void phase0(const Args& a, char* lds) {
    const int tid = threadIdx.x, lane = tid & 63, wave = tid >> 6;
    unsigned char* ws = a.ws;
    if (blockIdx.x == 0) { unsigned* bw = (unsigned*)(ws + WS_BAR); for (int i = tid; i < 4096; i += 512) bw[i] = 0u; }
    if (blockIdx.x == 1 || gridDim.x == 1) { unsigned* pc = (unsigned*)(ws + WS_PCNT); for (int i = tid; i < 128 * 64; i += 512) pc[i] = 0u; }
    float* sv = (float*)lds; float* red = (float*)(lds + 24576);
    const float* c = a.in[1]; const float* cc = a.in[3]; const float* w_ada = a.in[4]; const float* b_ada = a.in[5];
    float* MOD = (float*)(ws + WS_MOD);
    if (blockIdx.x < 192) {
        for (int i = tid; i < 3 * 2048; i += 512) { const float v = i < 4096 ? c[i] : cc[i - 4096]; sv[i] = siluf(v); }
        __syncthreads();
        for (int cgp = blockIdx.x; cgp < 192; cgp += gridDim.x) {
            const int sub = tid & 7, rg = tid >> 3;
            v4f acc0 = {0.f, 0.f, 0.f, 0.f}, acc1 = acc0, acc2 = acc0;
            const float* wp = w_ada + (size_t)(rg * 32) * 6144 + cgp * 32 + sub * 4;
#pragma unroll 8
            for (int rr = 0; rr < 32; ++rr) { const v4f w = *(const v4f*)(wp + (size_t)rr * 6144); const int k = rg * 32 + rr; acc0 += sv[k] * w; acc1 += sv[2048 + k] * w; acc2 += sv[4096 + k] * w; }
            float* rp = red + rg * 96 + sub * 4;
            *(v4f*)(rp) = acc0; *(v4f*)(rp + 32) = acc1; *(v4f*)(rp + 64) = acc2;
            __syncthreads();
            if (tid < 96) { float s = 0.f; for (int g = 0; g < 64; ++g) s += red[g * 96 + tid]; const int v = tid >> 5, cix = tid & 31; MOD[v * 6144 + cgp * 32 + cix] = s + b_ada[cgp * 32 + cix]; }
            __syncthreads();
        }
    }
}
__device__ __forceinline__ void phase_wcopy(const Args& a, char* lds) {
    const int tid = threadIdx.x, lane = tid & 63, wave = tid >> 6;
    unsigned char* ws = a.ws;
    float* scr = (float*)(lds + wave * 8448);
    const int gw = blockIdx.x * 8 + wave, NGW = gridDim.x * 8;
    const float* w_in = a.in[7]; const float* w_out = a.in[14];
    bfu* WinT = (bfu*)((unsigned char*)a.out + OUT_WIN); bfu* WoutT = (bfu*)(ws + WS_WOUT);
    constexpr int I_IN = 32 * 209, I_OUT = 32 * 64;
    for (int it = gw; it < I_IN + I_OUT; it += NGW) {
        if (it < I_IN) { const int kb = it / 209, nb = it % 209, n0 = nb * 32;
            const int dn0 = n0 < 4096 ? n0 : (n0 < 4128 ? n0 + 2560 : (n0 < 5664 ? n0 + 992 : n0 - 1568));
            transpose_item(w_in, INC, WinT, DM, kb * 64, n0, dn0, scr, lane);
        } else { const int r = it - I_IN, kb = r / 64, nb = r % 64; transpose_item(w_out, DM, WoutT, DM, kb * 64, nb * 32, nb * 32, scr, lane); }
    }
    { v4u z = {0u, 0u, 0u, 0u}; v4u* pz = (v4u*)(WinT + (size_t)INC * DM); const int n16 = (NPAD - INC) * DM * 2 / 16;
      for (int i = blockIdx.x * 512 + tid; i < n16; i += gridDim.x * 512) pz[i] = z; }
}

__device__ __forceinline__ void phase1(const Args& a) {
    const int tid = threadIdx.x, lane = tid & 63, wave = tid >> 6;
    const int gw = blockIdx.x * 8 + wave, NGW = gridDim.x * 8;
    const float* x = a.in[0]; const float* ctx = a.in[2]; const float* nw = a.in[6];
    const float* MOD = (const float*)(a.ws + WS_MOD); bfu* H = (bfu*)((unsigned char*)a.out + OUT_H);
    for (int row = gw; row < MROWS; row += NGW) {
        const int b = row / TOK, tl = row - b * TOK;
        const float* src = tl < CTXL ? ctx + ((size_t)b * CTXL + tl) * DM : x + ((size_t)b * SEQ + (tl - CTXL)) * DM;
        const float* shift = MOD + (tl < CTXL ? 2 : b) * 6144; const float* scale = shift + 2048;
        v4f v[8]; float ss = 0.f;
#pragma unroll
        for (int j = 0; j < 8; ++j) { v[j] = ((const v4f*)src)[lane + 64 * j]; ss += (v[j].x * v[j].x + v[j].y * v[j].y) + (v[j].z * v[j].z + v[j].w * v[j].w); }
        const float rstd = rsqrtf(wave_sum(ss) * (1.f / DM) + EPSF);
#pragma unroll
        for (int j = 0; j < 8; ++j) { const int col = (lane + 64 * j) * 4; const v4f w = *(const v4f*)(nw + col), sc = *(const v4f*)(scale + col), sh = *(const v4f*)(shift + col);
            const v4f y = (v[j] * rstd) * w * (1.f + sc) + sh; u32x2 o; o.x = cvtpk2(y.x, y.y); o.y = cvtpk2(y.z, y.w);
            *(u32x2*)(H + (size_t)row * DM + col) = o; }
    }
}

struct EpiIn {
    static constexpr bool PERM = true, AFTER_DRAIN = false;
    bfu* qkvg; bfu* z; bfu* qkva; bfu* gates;
    __device__ __forceinline__ void operator()(const pg8::f32x4 (&acc)[2][2][4][2], const pg8::Unit& u, int wr, int wc, int fr, int fq) const {
        bfu* base; int ld, colb; const int pn = u.pn;
        if (pn < 12) { base = qkvg; ld = 3072; colb = pn * 256; } else if (pn < 20) { base = z; ld = 2048; colb = (pn - 12) * 256; }
        else if (pn < 26) { base = qkva; ld = 1536; colb = (pn - 20) * 256; } else { base = gates; ld = 32; colb = 0; }
        const bool gt = pn >= 26;
        const int row0 = u.pm * 256 + wr * 64 + fr, col0 = colb + wc * 32 + 8 * fq;
#pragma unroll
        for (int ai = 0; ai < 2; ++ai)
#pragma unroll
            for (int m = 0; m < 4; ++m) { bfu* rowp = base + (size_t)(row0 + ai * 128 + m * 16) * ld + col0;
#pragma unroll
                for (int bj = 0; bj < 2; ++bj) { const pg8::f32x4 v0 = acc[ai][bj][m][0], v1 = acc[ai][bj][m][1];
                    v4u w; w.x = cvtpk2(v0[0], v0[1]); w.y = cvtpk2(v0[2], v0[3]); w.z = cvtpk2(v1[0], v1[1]); w.w = cvtpk2(v1[2], v1[3]);
                    if (!gt) *(v4u*)(rowp + bj * 128) = w; else if (bj == 0 && wc == 0) *(v4u*)(rowp) = w; } }
    }
};
struct EpiOut {
    static constexpr bool PERM = false, AFTER_DRAIN = false;
    const float* x; const float* mod; float* out;
    __device__ __forceinline__ void operator()(const pg8::f32x4 (&acc)[2][2][4][2], const pg8::Unit& u, int wr, int wc, int fr, int fq) const {
        const int b = u.pm >= 65 ? 1 : 0; const float* gate = mod + b * 6144 + 4096;
        const int col0 = u.pn * 256 + wc * 32 + 4 * fq;
        v4f g[2][2];
#pragma unroll
        for (int bj = 0; bj < 2; ++bj)
#pragma unroll
            for (int n = 0; n < 2; ++n) g[bj][n] = *(const v4f*)(gate + col0 + bj * 128 + n * 16);
#pragma unroll
        for (int ai = 0; ai < 2; ++ai) {
            v4f xv[4][2][2];
#pragma unroll
            for (int m = 0; m < 4; ++m) { const int row = u.pm * 256 + ai * 128 + wr * 64 + m * 16 + fr; const size_t off = (size_t)(row - 256 * (b + 1)) * DM + col0;
#pragma unroll
                for (int bj = 0; bj < 2; ++bj)
#pragma unroll
                    for (int n = 0; n < 2; ++n) xv[m][bj][n] = *(const v4f*)(x + off + bj * 128 + n * 16); }
#pragma unroll
            for (int m = 0; m < 4; ++m) { const int row = u.pm * 256 + ai * 128 + wr * 64 + m * 16 + fr; const size_t off = (size_t)(row - 256 * (b + 1)) * DM + col0;
#pragma unroll
                for (int bj = 0; bj < 2; ++bj)
#pragma unroll
                    for (int n = 0; n < 2; ++n) { const pg8::f32x4 av = acc[ai][bj][m][n]; const v4f xx = xv[m][bj][n], gg = g[bj][n]; v4f o;
                        o.x = xx.x + gg.x * av[0]; o.y = xx.y + gg.y * av[1]; o.z = xx.z + gg.z * av[2]; o.w = xx.w + gg.w * av[3];
                        *(v4f*)(out + off + bj * 128 + n * 16) = o; } }
        }
    }
};
struct EpiOutNorm {
    static constexpr bool PERM = false, AFTER_DRAIN = false;
    const float* x; const float* mod; const float* fw; float* out; float* xbuf; unsigned* pcnt; char* lds;
    __device__ __forceinline__ void operator()(pg8::f32x4 (&acc)[2][2][4][2], const pg8::Unit& u, int wr, int wc, int fr, int fq) const {
        const int tid = threadIdx.x, lane = tid & 63, wid = __builtin_amdgcn_readfirstlane(tid >> 6);
        const int b = u.pm >= 65 ? 1 : 0; const float* gate = mod + b * 6144 + 4096; const int pml = u.pm - 1 - b;
        const int col0 = u.pn * 256 + wc * 32 + 4 * fq;
        float* P = (float*)(lds); float* S = (float*)(lds + 4096); volatile unsigned* flag = (volatile unsigned*)(lds + 5120);
        v4f g[2][2];
#pragma unroll
        for (int bj = 0; bj < 2; ++bj)
#pragma unroll
            for (int n = 0; n < 2; ++n) g[bj][n] = *(const v4f*)(gate + col0 + bj * 128 + n * 16);
#pragma unroll
        for (int ai = 0; ai < 2; ++ai) {
            v4f xv[4][2][2];
#pragma unroll
            for (int m = 0; m < 4; ++m) { const size_t off = (size_t)(pml * 256 + ai * 128 + wr * 64 + m * 16 + fr) * DM + col0;
#pragma unroll
                for (int bj = 0; bj < 2; ++bj)
#pragma unroll
                    for (int n = 0; n < 2; ++n) xv[m][bj][n] = *(const v4f*)(x + off + bj * 128 + n * 16); }
#pragma unroll
            for (int m = 0; m < 4; ++m) { float sq = 0.f;
#pragma unroll
                for (int bj = 0; bj < 2; ++bj)
#pragma unroll
                    for (int n = 0; n < 2; ++n) { pg8::f32x4 av = acc[ai][bj][m][n]; const v4f xx = xv[m][bj][n], gg = g[bj][n];
                        av[0] = xx.x + gg.x * av[0]; av[1] = xx.y + gg.y * av[1]; av[2] = xx.z + gg.z * av[2]; av[3] = xx.w + gg.w * av[3];
                        sq += (av[0] * av[0] + av[1] * av[1]) + (av[2] * av[2] + av[3] * av[3]); acc[ai][bj][m][n] = av; }
                sq += __shfl_xor(sq, 16); sq += __shfl_xor(sq, 32);
                if (fq == 0) P[(ai * 128 + wr * 64 + m * 16 + fr) * 4 + wc] = sq; }
        }
        asm volatile("s_waitcnt lgkmcnt(0)" ::: "memory"); __builtin_amdgcn_s_barrier(); asm volatile("" ::: "memory");
        unsigned* cnt = pcnt + 64 * pml;
        if (tid < 256) { const float tot = (P[tid * 4 + 0] + P[tid * 4 + 1]) + (P[tid * 4 + 2] + P[tid * 4 + 3]);
            __hip_atomic_store(xbuf + ((size_t)pml * 256 + tid) * 8 + u.pn, tot, __ATOMIC_RELAXED, __HIP_MEMORY_SCOPE_AGENT); }
        asm volatile("s_waitcnt vmcnt(0)" ::: "memory");
        if (wid < 4 && lane == 0) __hip_atomic_fetch_add(cnt, 1u, __ATOMIC_RELAXED, __HIP_MEMORY_SCOPE_AGENT);
        if (wid == 0) { unsigned spins = 0u;
            for (;;) { if ((unsigned)__builtin_amdgcn_readfirstlane(__hip_atomic_load(cnt, __ATOMIC_RELAXED, __HIP_MEMORY_SCOPE_AGENT)) >= 32u) break;
                if (++spins > (1u << 18)) break; __builtin_amdgcn_s_sleep(2); }
            __builtin_amdgcn_fence(__ATOMIC_ACQUIRE, "agent");
            if (lane == 0) *flag = spins; }
        asm volatile("s_waitcnt vmcnt(0) lgkmcnt(0)" ::: "memory"); __builtin_amdgcn_s_barrier(); asm volatile("" ::: "memory");
        if (tid < 256) { const float* sl = xbuf + ((size_t)pml * 256 + tid) * 8; float t8 = 0.f;
#pragma unroll
            for (int p = 0; p < 8; ++p) t8 += __hip_atomic_load(sl + p, __ATOMIC_RELAXED, __HIP_MEMORY_SCOPE_AGENT);
            S[tid] = rsqrtf(t8 * (1.f / DM) + EPSF); }
        asm volatile("s_waitcnt vmcnt(0) lgkmcnt(0)" ::: "memory"); __builtin_amdgcn_s_barrier(); asm volatile("" ::: "memory");
        v4f w4[2][2];
#pragma unroll
        for (int bj = 0; bj < 2; ++bj)
#pragma unroll
            for (int n = 0; n < 2; ++n) w4[bj][n] = *(const v4f*)(fw + col0 + bj * 128 + n * 16);
#pragma unroll
        for (int ai = 0; ai < 2; ++ai)
#pragma unroll
            for (int m = 0; m < 4; ++m) { const int r = ai * 128 + wr * 64 + m * 16 + fr; const float rs = S[r]; const size_t off = (size_t)(pml * 256 + r) * DM + col0;
#pragma unroll
                for (int bj = 0; bj < 2; ++bj)
#pragma unroll
                    for (int n = 0; n < 2; ++n) { const pg8::f32x4 av = acc[ai][bj][m][n]; const v4f ww = w4[bj][n]; v4f o;
                        o.x = av[0] * rs * ww.x; o.y = av[1] * rs * ww.y; o.z = av[2] * rs * ww.z; o.w = av[3] * rs * ww.w;
                        *(v4f*)(out + off + bj * 128 + n * 16) = o; } }
        asm volatile("s_waitcnt lgkmcnt(0)" ::: "memory");
    }
};
struct OutOrderN { int G, vc;
    __device__ __forceinline__ bool next(int i, pg8::Unit& u) const { const int L = i * G + vc; if (L >= 1024) return false; const int p = L >> 3; u.pm = p < 64 ? p + 1 : p + 2; u.pn = L & 7; return true; }
    __device__ __forceinline__ void a_ready(const pg8::Unit&) const {}
    __device__ __forceinline__ void done(const pg8::Unit&) const {}
};
struct OutOrder { pg8::StaticOrder so;
    __device__ __forceinline__ bool next(int i, pg8::Unit& u) const { if (!so.next(i, u)) return false; u.pm = u.pm < 64 ? u.pm + 1 : u.pm + 2; return true; }
    __device__ __forceinline__ void a_ready(const pg8::Unit&) const {}
    __device__ __forceinline__ void done(const pg8::Unit&) const {}
};

struct InOrder { pg8::StaticOrder so; int limit, mode;
    __device__ __forceinline__ bool next(int i, pg8::Unit& u) const { if ((long)i * so.G + so.c >= limit) return false; if (!so.next(i, u)) return false; u.pn = mode ? u.pn + 12 : (u.pn < 12 ? u.pn : 26); return true; }
    __device__ __forceinline__ void a_ready(const pg8::Unit&) const {}
    __device__ __forceinline__ void done(const pg8::Unit&) const {}
};
__device__ __forceinline__ void phase3a(const Args& a) {
    const int tid = threadIdx.x, lane = tid & 63, wave = tid >> 6;
    const int gw = blockIdx.x * 8 + wave, NGW = gridDim.x * 8;
    bfu* QKVA = (bfu*)(a.ws + WS_QKVA); const float* qnw = a.in[12]; const float* knw = a.in[13];
    const int ax = lane >> 5, i = lane & 31, d1 = ax * 64 + i, d2 = d1 + 32;
    const float inv = exp2f(-(float)i * (13.287712379549449f / 32.f));
    const float qw1 = qnw[d1], qw2 = qnw[d2], kw1 = knw[d1], kw2 = knw[d2];
    for (int row = gw; row < MROWS; row += NGW) {
        const int b = row / TOK, tl = row - b * TOK; const bool isctx = tl < CTXL; const int t = tl - CTXL;
        float cs = 1.f, sn = 0.f;
        if (!isctx) { const float pos = (float)(ax == 0 ? (t >> 6) : (t & 63)); const float ang = pos * inv; float rev = ang * 0.15915494309189535f; rev -= floorf(rev);
            sn = __builtin_amdgcn_sinf(rev); cs = __builtin_amdgcn_cosf(rev); }
        bfu* base = QKVA + (size_t)row * 1536;
        { bfu* VC = (bfu*)(a.ws + WS_VC);
#pragma unroll
          for (int kv = 0; kv < 2; ++kv) *(unsigned*)(VC + ((size_t)(b * 2 + kv) * TOK + tl) * 128 + 2 * lane) = *(const unsigned*)(base + 1280 + kv * 128 + 2 * lane); }
        float xa[10], xb[10];
#pragma unroll
        for (int hh = 0; hh < 10; ++hh) { xa[hh] = bf2f(base[hh * 128 + d1]); xb[hh] = bf2f(base[hh * 128 + d2]); }
#pragma unroll
        for (int hh = 0; hh < 10; ++hh) { bfu* p = base + hh * 128;
            const float x1 = xa[hh], x2 = xb[hh];
            const float r = rsqrtf(wave_sum(x1 * x1 + x2 * x2) * (1.f / 128.f) + EPSF);
            const float y1 = x1 * r * (hh < 8 ? qw1 : kw1), y2 = x2 * r * (hh < 8 ? qw2 : kw2);
            const float o1 = y1 * cs - y2 * sn, o2 = y2 * cs + y1 * sn;
            bfu* q = hh < 8 ? p : (bfu*)(a.ws + WS_KC) + ((size_t)(b * 2 + (hh - 8)) * TOK + tl) * 128;
            q[d1] = (bfu)(cvtpk2(o1, 0.f) & 0xffffu); q[d2] = (bfu)(cvtpk2(o2, 0.f) & 0xffffu); }
    }
}

constexpr int PL_QS = 0, PL_KS = 17408, PL_KST = 34816, PL_VST = 53248, PL_AMAT = 71680, PL_TU = 104448, PL_SM = 141312;
__device__ __forceinline__ void prep_load(const Args& a, int it, unsigned (&raw)[12][3], float (&cw)[5][3][2], float (&gpre)[4]) {
    int tid_o = threadIdx.x; asm volatile("" : "+v"(tid_o));
    const int tid = tid_o, lane = tid & 63, wave = __builtin_amdgcn_readfirstlane(tid >> 6);
    const int b = it / (GH * NCH), h = (it / NCH) % GH, cidx = it % NCH;
    const int rowbase = b * TOK + (cidx < 4 ? cidx * 64 : CTXL + (cidx - 4) * 64);
    const int seg_lo = b * TOK + (cidx < 4 ? 0 : CTXL), seg_hi = cidx < 4 ? b * TOK + CTXL : (b + 1) * TOK;
    const bfu* QKVG = (const bfu*)(a.ws + WS_QKVG); const bfu* GATES = (const bfu*)(a.ws + WS_GATES);
    const float* conv_w = a.in[8];
#pragma unroll
    for (int j = 0; j < 5; ++j)
#pragma unroll
        for (int s = 0; s < 3; ++s) { const float* p = conv_w + j * 3072 + s * 1024 + h * 128 + 2 * lane; cw[j][s][0] = p[0]; cw[j][s][1] = p[1]; }
    const int t0 = wave * 8;
#pragma unroll
    for (int rr = 0; rr < 12; ++rr) { const int rg = rowbase + t0 - 2 + rr; const bool ok = rg >= seg_lo && rg < seg_hi;
#pragma unroll
        for (int s = 0; s < 3; ++s) raw[rr][s] = ok ? *(const unsigned*)(QKVG + (size_t)rg * 3072 + s * 1024 + h * 128 + 2 * lane) : 0u; }
    { const bfu* gp = GATES + (size_t)(rowbase + lane) * 32 + h; gpre[0] = bf2f(gp[0]); gpre[1] = bf2f(gp[8]); gpre[2] = bf2f(gp[16]); gpre[3] = bf2f(gp[24]); }
}
#define PBAR() do { asm volatile("s_waitcnt lgkmcnt(0)" ::: "memory"); __builtin_amdgcn_s_barrier(); asm volatile("" ::: "memory"); } while (0)
__device__ __forceinline__ void prep_item(const Args& a, char* lds, int it, int it_next, unsigned (&raw)[12][3], float (&cw)[5][3][2], float (&gpre)[4]) {
    int tid_o = threadIdx.x; asm volatile("" : "+v"(tid_o));
    const int tid = tid_o, lane = tid & 63, wave = __builtin_amdgcn_readfirstlane(tid >> 6);
    const int h = (it / NCH) % GH;
    unsigned char* item = a.ws + WS_FRAG + (size_t)it * ITEM_BYTES;
    bfu* QS = (bfu*)(lds + PL_QS); bfu* KS = (bfu*)(lds + PL_KS); bfu* KST = (bfu*)(lds + PL_KST); bfu* VST = (bfu*)(lds + PL_VST);
    float* SM = (float*)(lds + PL_SM);
    const int hi = lane >> 5, n32 = lane & 31;
    {
        const int t0 = wave * 8;
        float yq[8][2], yk[8][2], yv[8][2], sq[8], sk[8];
#pragma unroll
        for (int tt = 0; tt < 8; ++tt) {
            float y[3][2];
#pragma unroll
            for (int s = 0; s < 3; ++s) { float a0 = 0.f, a1 = 0.f;
#pragma unroll
                for (int j = 0; j < 5; ++j) { a0 += bflo(raw[tt + j][s]) * cw[j][s][0]; a1 += bfhi(raw[tt + j][s]) * cw[j][s][1]; }
                y[s][0] = siluf(a0); y[s][1] = siluf(a1); }
            yq[tt][0] = y[0][0]; yq[tt][1] = y[0][1]; yk[tt][0] = y[1][0]; yk[tt][1] = y[1][1]; yv[tt][0] = y[2][0]; yv[tt][1] = y[2][1];
            sq[tt] = y[0][0] * y[0][0] + y[0][1] * y[0][1]; sk[tt] = y[1][0] * y[1][0] + y[1][1] * y[1][1]; }
#pragma unroll
        for (int o = 1; o < 64; o <<= 1) {
#pragma unroll
            for (int tt = 0; tt < 8; ++tt) { sq[tt] += __shfl_xor(sq[tt], o); sk[tt] += __shfl_xor(sk[tt], o); } }
        unsigned kpk[8], vpk[8];
#pragma unroll
        for (int tt = 0; tt < 8; ++tt) { const int t = t0 + tt;
            const float rq = rsqrtf(sq[tt] + EPSF) * 0.08838834764831845f, rk = rsqrtf(sk[tt] + EPSF);
            const unsigned qp = cvtpk2(yq[tt][0] * rq, yq[tt][1] * rq); kpk[tt] = cvtpk2(yk[tt][0] * rk, yk[tt][1] * rk); vpk[tt] = cvtpk2(yv[tt][0], yv[tt][1]);
            *(unsigned*)(QS + t * 136 + 2 * lane) = qp; *(unsigned*)(KS + t * 136 + 2 * lane) = kpk[tt]; }
        {
            v4u k0, k1, v0, v1;
#pragma unroll
            for (int i = 0; i < 4; ++i) { k0[i] = (kpk[2 * i] & 0xffffu) | (kpk[2 * i + 1] << 16); k1[i] = (kpk[2 * i] >> 16) | (kpk[2 * i + 1] & 0xffff0000u);
                v0[i] = (vpk[2 * i] & 0xffffu) | (vpk[2 * i + 1] << 16); v1[i] = (vpk[2 * i] >> 16) | (vpk[2 * i + 1] & 0xffff0000u); }
            *(v4u*)(KST + (2 * lane) * 72 + t0) = k0; *(v4u*)(KST + (2 * lane + 1) * 72 + t0) = k1;
            *(v4u*)(VST + (2 * lane) * 72 + t0) = v0; *(v4u*)(VST + (2 * lane + 1) * 72 + t0) = v1; }
        {
            const float af = gpre[2] + a.in[10][h], ab = gpre[3] + a.in[10][8 + h];
            const float gf0 = -__expf(a.in[9][h]) * (fmaxf(af, 0.f) + log1pf(__expf(-fabsf(af)))), gb0 = -__expf(a.in[9][8 + h]) * (fmaxf(ab, 0.f) + log1pf(__expf(-fabsf(ab))));
            float xf = gf0, xb = gb0;
#pragma unroll
            for (int off = 1; off < 64; off <<= 1) { const float yf = __shfl_up(xf, off), yb = __shfl_down(xb, off); if (lane >= off) xf += yf; if (lane + off < 64) xb += yb; }
            const float glf = __shfl(xf, 63), glb = __shfl(xb, 0);
            if (wave < 2) { const int dir = wave; const float xg = dir ? xb : xf, gl = dir ? glb : glf, beta = 1.f / (1.f + __expf(-(dir ? gpre[1] : gpre[0])));
                const float eg = __expf(xg), ek = __expf(gl - xg);
                SM[dir * 64 + lane] = beta; SM[256 + dir * 64 + lane] = xg;
                float* SC = (float*)(item + 32768 + dir * DIR_BYTES + 24576); SC[lane] = eg; SC[64 + lane] = ek; SC[192 + lane] = beta; if (lane == 0) SC[128] = __expf(gl); } }
        if (it_next >= 0) prep_load(a, it_next, raw, cw, gpre);
    }
    PBAR();
#pragma unroll
    for (int p = 0; p < 4; ++p) { const int ci = tid + 512 * p, f = ci >> 6, ln = ci & 63, r = ln & 31, hh = ln >> 5; const bfu* src;
        if (f < 16) { const int mt = f >> 3, ks = f & 7; src = QS + (32 * mt + r) * 136 + 16 * ks + 8 * hh; }
        else { const int f2 = f - 16, mt = f2 >> 2, ks = f2 & 3; src = KST + (32 * mt + r) * 72 + 16 * ks + 8 * hh; }
        *(v4u*)(item + (size_t)ci * 16) = *(const v4u*)src; }
#pragma unroll
    for (int p = 0; p < 2; ++p) { const int ci = tid + 512 * p, f = ci >> 6, ln = ci & 63, r = ln & 31, hh = ln >> 5, nt = f >> 2, ks = f & 3;
        const v4u vv = *(const v4u*)(VST + (32 * nt + r) * 72 + 16 * ks + 8 * hh);
        *(v4u*)(item + 32768 + (size_t)ci * 16) = vv; *(v4u*)(item + 32768 + DIR_BYTES + (size_t)ci * 16) = vv; }
    { const int which = wave >> 2, ti = (wave >> 1) & 1, tj = wave & 1; f32x16 c = {};
      if (which == 0) {
#pragma unroll
          for (int ks = 0; ks < 8; ++ks) { const v8s af = *(const v8s*)(KS + (32 * ti + n32) * 136 + 16 * ks + 8 * hi), bf = *(const v8s*)(KS + (32 * tj + n32) * 136 + 16 * ks + 8 * hi); c = MFMA32(af, bf, c); }
          const int j = 32 * tj + n32;
#pragma unroll 1
          for (int dir = 0; dir < 2; ++dir) { const float gj = SM[256 + dir * 64 + j]; const int lj = dir ? 63 - j : j;
#pragma unroll
              for (int r = 0; r < 16; ++r) { const int i = 32 * ti + crow_(r, hi); const bool cond = dir ? (j > i) : (j < i);
                  const float v = cond ? SM[dir * 64 + i] * c[r] * __expf(fminf(SM[256 + dir * 64 + i] - gj, 0.f)) : 0.f; const int li = dir ? 63 - i : i;
                  ((float*)(item + 32768 + dir * DIR_BYTES + 25600))[li * 64 + lj] = v; } }
      } else {
#pragma unroll
          for (int ks = 0; ks < 8; ++ks) { const v8s af = *(const v8s*)(KS + (32 * tj + n32) * 136 + 16 * ks + 8 * hi), bf = *(const v8s*)(QS + (32 * ti + n32) * 136 + 16 * ks + 8 * hi); c = MFMA32(af, bf, c); }
          const int i = 32 * ti + n32;
#pragma unroll 1
          for (int dir = 0; dir < 2; ++dir) { const float gi = SM[256 + dir * 64 + i]; f32x16 p;
#pragma unroll
              for (int r = 0; r < 16; ++r) { const int j = 32 * tj + crow_(r, hi); const bool cond = dir ? (j >= i) : (j <= i);
                  p[r] = cond ? c[r] * __expf(fminf(gi - SM[256 + dir * 64 + j], 0.f)) : 0.f; }
              unsigned char* dst = item + 32768 + dir * DIR_BYTES + 16384;
              *(v8s*)(dst + ((ti * 4 + 2 * tj + 0) * 64 + lane) * 16) = pk4<0>(p); *(v8s*)(dst + ((ti * 4 + 2 * tj + 1) * 64 + lane) * 16) = pk4<8>(p); }
      } }
    PBAR();
}
__device__ __forceinline__ int tswz(int row, int col) { return row * 128 + ((((col >> 3) ^ (row & 7))) << 4) + (col & 7) * 2; }
__device__ __forceinline__ void prep_part2(const Args& a, char* lds, int it, int dir) {
    int tid_o = threadIdx.x; asm volatile("" : "+v"(tid_o));
    const int lane = tid_o & 63, wave = __builtin_amdgcn_readfirstlane(tid_o >> 6), hi = lane >> 5, n32 = lane & 31;
    unsigned char* item = a.ws + WS_FRAG + (size_t)it * ITEM_BYTES; unsigned char* dbase = item + 32768 + dir * DIR_BYTES;
    char* wl = lds + wave * 16384; float* Am = (float*)wl;
    { const v4f* Ag = (const v4f*)(dbase + 25600); v4f t_[16];
#pragma unroll
      for (int i = 0; i < 16; ++i) t_[i] = Ag[lane + 64 * i];
#pragma unroll
      for (int i = 0; i < 16; ++i) ((v4f*)Am)[lane + 64 * i] = t_[i]; }
    const float* SC = (const float*)(dbase + 24576);
    const int oc = dir ? 63 - lane : lane; const float bc = SC[192 + oc], bw = -bc * SC[oc];
    asm volatile("s_waitcnt vmcnt(0) lgkmcnt(0)" ::: "memory");
    float T[64];
#pragma unroll
    for (int i = 0; i < 64; ++i) T[i] = 0.f;
#pragma unroll
    for (int i = 0; i < 64; ++i) { float acc = (i == lane) ? 1.f : 0.f;
#pragma unroll
        for (int j4 = 0; j4 < (i + 3) / 4; ++j4) { const v4f av = *(const v4f*)(Am + i * 64 + 4 * j4);
            acc -= av.x * T[4 * j4]; acc -= av.y * T[4 * j4 + 1]; acc -= av.z * T[4 * j4 + 2]; acc -= av.w * T[4 * j4 + 3]; }
        T[i] = acc; asm volatile("" ::: "memory"); __builtin_amdgcn_sched_barrier(0); }
    asm volatile("s_waitcnt lgkmcnt(0)" ::: "memory");
    char* TU = wl; char* TW = wl + 8192;
#pragma unroll
    for (int i = 0; i < 64; ++i) { const int oi = dir ? 63 - i : i; const unsigned w = cvtpk2(T[i] * bc, T[i] * bw); *(bfu*)(TU + tswz(oi, oc)) = (bfu)(w & 0xffffu); *(bfu*)(TW + tswz(oi, oc)) = (bfu)(w >> 16); }
    asm volatile("s_waitcnt lgkmcnt(0)" ::: "memory");
#pragma unroll 1
    for (int nh = 0; nh < 2; ++nh) { v8s vf[8];
#pragma unroll
        for (int f = 0; f < 8; ++f) vf[f] = *(const v8s*)(dbase + ((nh * 8 + f) * 64 + lane) * 16);
#pragma unroll
        for (int nn = 0; nn < 2; ++nn) { const int nt = nh * 2 + nn;
#pragma unroll
        for (int mt = 0; mt < 2; ++mt) { f32x16 c = {};
#pragma unroll
            for (int ks = 0; ks < 4; ++ks) { const v8s af = *(const v8s*)(TU + tswz(32 * mt + n32, 16 * ks + 8 * hi)); c = MFMA32(af, vf[nn * 4 + ks], c); }
            v4u w0, w1; w0.x = cvtpk2(c[0], c[1]); w0.y = cvtpk2(c[2], c[3]); w0.z = cvtpk2(c[4], c[5]); w0.w = cvtpk2(c[6], c[7]);
            w1.x = cvtpk2(c[8], c[9]); w1.y = cvtpk2(c[10], c[11]); w1.z = cvtpk2(c[12], c[13]); w1.w = cvtpk2(c[14], c[15]);
            unsigned char* up = dbase + 25600 + ((nt * 2 + mt) * 64 + lane) * 32; *(v4u*)up = w0; *(v4u*)(up + 16) = w1; } } }
    v8s wout[16];
#pragma unroll
    for (int nt = 0; nt < 4; ++nt) { v8s kf[4];
#pragma unroll
        for (int ks = 0; ks < 4; ++ks) kf[ks] = *(const v8s*)(item + 16384 + ((nt * 4 + ks) * 64 + lane) * 16);
#pragma unroll
        for (int mt = 0; mt < 2; ++mt) { f32x16 c = {};
#pragma unroll
            for (int ks = 0; ks < 4; ++ks) { const v8s bf = *(const v8s*)(TW + tswz(32 * mt + n32, 16 * ks + 8 * hi)); c = MFMA32(kf[ks], bf, c); }
            wout[(mt * 4 + nt) * 2 + 0] = pk4<0>(c); wout[(mt * 4 + nt) * 2 + 1] = pk4<8>(c); } }
#pragma unroll
    for (int f = 0; f < 16; ++f) *(v8s*)(dbase + (f * 64 + lane) * 16) = wout[f];
    asm volatile("s_waitcnt vmcnt(0) lgkmcnt(0)" ::: "memory");
}

__device__ __forceinline__ int cidx_of(int step, int dir) { return dir == 0 ? step : (step < 4 ? 3 - step : 263 - step); }
constexpr int SBUF = 32768 + 25600 + 16384;
__device__ __forceinline__ void scan_step(const char* bufp, bool store, bfu* op, int wsl, f32x16& S0, f32x16& S1, f32x16& S2, f32x16& S3, v8s (&Sb)[8], int lane, int hi) {
    f32x16 vn0, vn1, oq0 = {}, oq1 = {};
    v4u ureg[4]; { const char* up = bufp + 58368 + ((wsl * 2) * 64 + lane) * 32; ureg[0] = *(const v4u*)up; ureg[1] = *(const v4u*)(up + 16); ureg[2] = *(const v4u*)(up + 2048); ureg[3] = *(const v4u*)(up + 2048 + 16); }
#pragma unroll
    for (int i = 0; i < 4; ++i) { vn0[2 * i] = bflo(ureg[0][i]); vn0[2 * i + 1] = bfhi(ureg[0][i]); vn0[8 + 2 * i] = bflo(ureg[1][i]); vn0[8 + 2 * i + 1] = bfhi(ureg[1][i]);
        vn1[2 * i] = bflo(ureg[2][i]); vn1[2 * i + 1] = bfhi(ureg[2][i]); vn1[8 + 2 * i] = bflo(ureg[3][i]); vn1[8 + 2 * i + 1] = bfhi(ureg[3][i]); }
#pragma unroll
    for (int ks = 0; ks < 8; ++ks) {
        const v8s w0 = *(const v8s*)(bufp + 32768 + (ks) * 1024 + lane * 16), w1 = *(const v8s*)(bufp + 32768 + (8 + ks) * 1024 + lane * 16);
        const v8s q0 = *(const v8s*)(bufp + (ks) * 1024 + lane * 16), q1 = *(const v8s*)(bufp + (8 + ks) * 1024 + lane * 16);
        vn0 = MFMA32(w0, Sb[ks], vn0); vn1 = MFMA32(w1, Sb[ks], vn1); oq0 = MFMA32(q0, Sb[ks], oq0); oq1 = MFMA32(q1, Sb[ks], oq1); }
    const float* SC = (const float*)(bufp + 57344);
    f32x16 vs0, vs1;
#pragma unroll
    for (int q = 0; q < 4; ++q) { const v4f e0 = *(const v4f*)(SC + 64 + 8 * q + 4 * hi), e1 = *(const v4f*)(SC + 64 + 32 + 8 * q + 4 * hi);
        const v4f g0 = *(const v4f*)(SC + 8 * q + 4 * hi), g1 = *(const v4f*)(SC + 32 + 8 * q + 4 * hi);
#pragma unroll
        for (int j = 0; j < 4; ++j) { vs0[4 * q + j] = vn0[4 * q + j] * e0[j]; vs1[4 * q + j] = vn1[4 * q + j] * e1[j]; oq0[4 * q + j] *= g0[j]; oq1[4 * q + j] *= g1[j]; } }
    v8s Vb[4], Vs[4];
    Vb[0] = pk4<0>(vn0); Vb[1] = pk4<8>(vn0); Vb[2] = pk4<0>(vn1); Vb[3] = pk4<8>(vn1);
    Vs[0] = pk4<0>(vs0); Vs[1] = pk4<8>(vs0); Vs[2] = pk4<0>(vs1); Vs[3] = pk4<8>(vs1);
    const float eL = SC[128];
    S0 = S0 * eL; S1 = S1 * eL; S2 = S2 * eL; S3 = S3 * eL;
#pragma unroll
    for (int ks = 0; ks < 4; ++ks) {
        const v8s k0 = *(const v8s*)(bufp + 16384 + (0 * 4 + ks) * 1024 + lane * 16), k1 = *(const v8s*)(bufp + 16384 + (1 * 4 + ks) * 1024 + lane * 16);
        const v8s k2 = *(const v8s*)(bufp + 16384 + (2 * 4 + ks) * 1024 + lane * 16), k3 = *(const v8s*)(bufp + 16384 + (3 * 4 + ks) * 1024 + lane * 16);
        const v8s i0 = *(const v8s*)(bufp + 49152 + (ks) * 1024 + lane * 16), i1 = *(const v8s*)(bufp + 49152 + (4 + ks) * 1024 + lane * 16);
        S0 = MFMA32(k0, Vs[ks], S0); S1 = MFMA32(k1, Vs[ks], S1); S2 = MFMA32(k2, Vs[ks], S2); S3 = MFMA32(k3, Vs[ks], S3);
        oq0 = MFMA32(i0, Vb[ks], oq0); oq1 = MFMA32(i1, Vb[ks], oq1); }
    Sb[0] = pk4<0>(S0); Sb[1] = pk4<8>(S0); Sb[2] = pk4<0>(S1); Sb[3] = pk4<8>(S1); Sb[4] = pk4<0>(S2); Sb[5] = pk4<8>(S2); Sb[6] = pk4<0>(S3); Sb[7] = pk4<8>(S3);
    if (store) {
#pragma unroll
        for (int r = 0; r < 16; ++r) { const int t = crow_(r, hi); op[(size_t)t * 1024] = (bfu)(cvtpk2(oq0[r], 0.f) & 0xffffu); op[(size_t)(32 + t) * 1024] = (bfu)(cvtpk2(oq1[r], 0.f) & 0xffffu); } }
}
__device__ __forceinline__ void scan_item(const Args& a, char* lds, int sid) {
    const int tid = threadIdx.x, lane = tid & 63, wave = tid >> 6, hi = lane >> 5, n32 = lane & 31;
    const int chain = sid >> 1, half = sid & 1;
    const int b = chain >> 4, h = (chain >> 1) & 7, dir = chain & 1;
    const unsigned char* frag0 = a.ws + WS_FRAG + (size_t)((b * GH + h) * NCH) * ITEM_BYTES;
    bfu* OG = (bfu*)(a.ws + WS_QKVG) + (size_t)dir * NB * SEQ * 1024;
    const bool loader = wave >= 4, idler = (wave == 2 || wave == 3); const int lt = tid - 256, wsl = half * 2 + wave;
#define LD_ISSUE(ST, step) do { const unsigned char* itp = frag0 + (size_t)cidx_of((step), dir) * ITEM_BYTES; const unsigned char* dp = itp + dir * DIR_BYTES; \
        _Pragma("unroll") for (int p = 0; p < 8; ++p) ST[p] = *(const v4u*)(itp + p * 4096 + lt * 16); \
        _Pragma("unroll") for (int p = 8; p < 18; ++p) ST[p] = *(const v4u*)(dp + p * 4096 + lt * 16); \
        if (lt < 64) ST[18] = *(const v4u*)(dp + 18 * 4096 + lt * 16); } while (0)
#define LD_WRITE(ST, bi) do { char* d = lds + (bi) * SBUF; _Pragma("unroll") for (int p = 0; p < 18; ++p) *(v4u*)(d + p * 4096 + lt * 16) = ST[p]; if (lt < 64) *(v4u*)(d + 18 * 4096 + lt * 16) = ST[18]; } while (0)
#define U_ISSUE(UR, step) do { const unsigned char* up = frag0 + (size_t)cidx_of((step), dir) * ITEM_BYTES + 32768 + dir * DIR_BYTES + 25600 + ((wsl * 2) * 64 + lane) * 32; \
        UR[0] = *(const v4u*)up; UR[1] = *(const v4u*)(up + 16); UR[2] = *(const v4u*)(up + 2048); UR[3] = *(const v4u*)(up + 2048 + 16); } while (0)
#define LBAR() do { asm volatile("s_waitcnt lgkmcnt(0)" ::: "memory"); __builtin_amdgcn_s_barrier(); asm volatile("" ::: "memory"); } while (0)
    if (loader) {
        v4u r0[19], r1[19];
        LD_ISSUE(r0, 0); LD_ISSUE(r1, 1); LD_WRITE(r0, 0); LD_ISSUE(r0, 2);
        for (int step = 0; step < NCH; step += 2) {
            LBAR();
            LD_WRITE(r1, 1); if (step + 3 < NCH) LD_ISSUE(r1, step + 3);
            LBAR();
            if (step + 2 < NCH) { LD_WRITE(r0, 0); if (step + 4 < NCH) LD_ISSUE(r0, step + 4); }
        }
    } else if (idler) {
        for (int step = 0; step < NCH; step += 2) { LBAR(); LBAR(); }
    } else {
        f32x16 S0 = {}, S1 = {}, S2 = {}, S3 = {}; v8s Sb[8];
#pragma unroll
        for (int i = 0; i < 8; ++i) Sb[i] = (v8s){0, 0, 0, 0, 0, 0, 0, 0};
        bfu* obase = OG + (size_t)b * SEQ * 1024 + h * 128 + 32 * wsl + n32;
        for (int step = 0; step < NCH; step += 2) {
            LBAR();
            { const int cidx = cidx_of(step, dir); scan_step(lds, cidx >= 4, obase + (size_t)(cidx - 4) * 64 * 1024, wsl, S0, S1, S2, S3, Sb, lane, hi); }
            LBAR();
            { const int cidx = cidx_of(step + 1, dir); scan_step(lds + SBUF, cidx >= 4, obase + (size_t)(cidx - 4) * 64 * 1024, wsl, S0, S1, S2, S3, Sb, lane, hi); }
        }
    }
    __syncthreads();
#undef LBAR
#undef LD_ISSUE
#undef LD_WRITE
#undef U_ISSUE
}

__device__ __forceinline__ void phase5(const Args& a) {
    const int tid = threadIdx.x, lane = tid & 63, wave = tid >> 6;
    const int gw = blockIdx.x * 8 + wave, NGW = gridDim.x * 8;
    const bfu* OF = (const bfu*)(a.ws + WS_QKVG); const bfu* OB = OF + (size_t)NB * SEQ * 1024; bfu* Z = (bfu*)(a.ws + WS_Z);
    const float gw0 = a.in[11][2 * lane], gw1 = a.in[11][2 * lane + 1];
    for (int lr = gw; lr < NB * SEQ; lr += NGW) { const int b = lr / SEQ; const size_t zrow = (size_t)lr + CTXL * (b + 1);
        unsigned ff[8], gg[8], zq[8];
#pragma unroll
        for (int hh = 0; hh < 8; ++hh) { const int c0 = hh * 128 + 2 * lane; ff[hh] = *(const unsigned*)(OF + (size_t)lr * 1024 + c0); gg[hh] = *(const unsigned*)(OB + (size_t)lr * 1024 + c0); zq[hh] = *(const unsigned*)(Z + zrow * 2048 + c0); }
#pragma unroll
        for (int hh = 0; hh < 8; ++hh) { const int c0 = hh * 128 + 2 * lane;
            const unsigned f = ff[hh], g = gg[hh], zz = zq[hh]; unsigned* zp = (unsigned*)(Z + zrow * 2048 + c0);
            const float o0 = bflo(f) + bflo(g), o1 = bfhi(f) + bfhi(g);
            const float r = rsqrtf(wave_sum(o0 * o0 + o1 * o1) * (1.f / 128.f) + EPSF);
            *zp = cvtpk2(o0 * r * gw0 * siluf(bflo(zz)), o1 * r * gw1 * siluf(bfhi(zz))); }
    }
}
__device__ __forceinline__ void phase7(const Args& a, float* dst) {
    const int tid = threadIdx.x, lane = tid & 63, wave = tid >> 6;
    const int gw = blockIdx.x * 8 + wave, NGW = gridDim.x * 8; const float* fw = a.in[15];
    for (int row = gw; row < NB * SEQ; row += NGW) { v4f* p = (v4f*)(a.out + (size_t)row * DM); v4f v[8]; float ss = 0.f;
#pragma unroll
        for (int j = 0; j < 8; ++j) { v[j] = p[lane + 64 * j]; ss += (v[j].x * v[j].x + v[j].y * v[j].y) + (v[j].z * v[j].z + v[j].w * v[j].w); }
        const float rstd = rsqrtf(wave_sum(ss) * (1.f / DM) + EPSF);
#pragma unroll
        for (int j = 0; j < 8; ++j) { const v4f w = ((const v4f*)fw)[lane + 64 * j]; ((v4f*)(dst + (size_t)row * DM))[lane + 64 * j] = (v[j] * rstd) * w; }
    }
}

#define LAS __attribute__((address_space(3)))
#define XB_TMO      128
#define XB_XCNT(j)  (256  + 64 * (j))
#define XB_XSUB(j)  (1280 + 64 * (j))
#define XB_XGEN(j)  (2304 + 64 * (j))
#define XB_TOP      3328
#define XB_TOPGEN   3392
#define XCD_BAR_WORDS 3456
#define XB_SPIN_CAP (1u << 18)

__device__ __forceinline__ unsigned xb_ld(unsigned* p)              { return __hip_atomic_load(p, __ATOMIC_RELAXED, __HIP_MEMORY_SCOPE_AGENT); }
__device__ __forceinline__ unsigned xb_add(unsigned* p, unsigned v) { return __hip_atomic_fetch_add(p, v, __ATOMIC_RELAXED, __HIP_MEMORY_SCOPE_AGENT); }
__device__ __forceinline__ unsigned xb_xcc_id() { return (unsigned)__builtin_amdgcn_s_getreg((3 << 11) | 20) & 0xFu; }
#define XB_SPIN(cond, bar) do { unsigned _sp = 0; while (cond) { __builtin_amdgcn_s_sleep(1); \
    if ((++_sp & 255u) == 0u) { if (xb_ld(&(bar)[XB_TMO])) break; if (_sp > XB_SPIN_CAP) { atomicAdd(&(bar)[XB_TMO], 1u); break; } } } } while (0)

struct XcdBarrier {
    unsigned* bar; unsigned x;
    volatile LAS unsigned* st;
};

__device__ __forceinline__ XcdBarrier xcd_barrier_post(unsigned* bar, volatile LAS unsigned* st) {
    XcdBarrier b; b.bar = bar; b.x = xb_xcc_id(); b.st = st;
    if (threadIdx.x == 0) (void)xb_add(&bar[XB_XCNT(b.x)], 1u);
    return b;
}
__device__ __forceinline__ void xcd_barrier_complete(unsigned* bar, unsigned x, unsigned& nloc, unsigned& nx) {
    const unsigned G = gridDim.x * gridDim.y * gridDim.z;
    unsigned sum, cnt, mine, sp = 0u;
    for (;;) {
        sum = 0u; cnt = 0u; mine = 0u;
#pragma unroll
        for (unsigned j = 0; j < 16; ++j) { const unsigned c = xb_ld(&bar[XB_XCNT(j)]); sum += c; cnt += (c > 0u) ? 1u : 0u; mine = (j == x) ? c : mine; }
        if (sum == G) break;
        __builtin_amdgcn_s_sleep(1);
        if ((++sp & 255u) == 0u) { if (xb_ld(&bar[XB_TMO])) break; if (sp > XB_SPIN_CAP) { atomicAdd(&bar[XB_TMO], 1u); break; } }
    }
    nloc = mine > 0u ? mine : 1u; nx = cnt > 0u ? cnt : 1u;
}

__device__ __forceinline__ void xcd_barrier(const XcdBarrier& b) {
    asm volatile("s_waitcnt vmcnt(0)" ::: "memory");
    __syncthreads();
    if (threadIdx.x == 0) {
        unsigned* bar = b.bar;
        __builtin_amdgcn_s_waitcnt(0);
        unsigned nloc = b.st[0], nx = b.st[1];
        if (nloc == 0u) { xcd_barrier_complete(bar, b.x, nloc, nx); b.st[0] = nloc; b.st[1] = nx; }
        const unsigned old = xb_add(&bar[XB_XSUB(b.x)], 1u);
        const unsigned gen = old / nloc;
        if (old + 1u == (gen + 1u) * nloc) {
            __builtin_amdgcn_fence(__ATOMIC_RELEASE, "agent");
            asm volatile("s_waitcnt vmcnt(0)" ::: "memory");
            const unsigned og = xb_add(&bar[XB_TOP], 1u);
            const unsigned tg = og / nx;
            if (og + 1u == (tg + 1u) * nx) xb_add(&bar[XB_TOPGEN], 1u);
            else XB_SPIN(xb_ld(&bar[XB_TOPGEN]) == tg, bar);
            __builtin_amdgcn_fence(__ATOMIC_ACQUIRE, "agent");
            xb_add(&bar[XB_XGEN(b.x)], 1u);
            asm volatile("s_waitcnt vmcnt(0)" ::: "memory");
        } else {
            XB_SPIN(xb_ld(&bar[XB_XGEN(b.x)]) == gen, bar);
            __builtin_amdgcn_fence(__ATOMIC_ACQUIRE, "agent");
            asm volatile("s_waitcnt vmcnt(0)" ::: "memory");
        }
    }
    __syncthreads();
}

__global__ void __launch_bounds__(512, 2) mega_fwd(Args a) {
    extern __shared__ __attribute__((aligned(16))) unsigned char lds_[];
    char* lds = (char*)lds_;
    cg::grid_group grid = cg::this_grid();
    volatile LAS unsigned* xst = (volatile LAS unsigned*)(lds_ + LDS_BYTES - 32);
    if (threadIdx.x < 2) xst[threadIdx.x] = 0u;
    __syncthreads();
    XcdBarrier xbar; xbar.bar = (unsigned*)(a.ws + WS_BAR); xbar.x = 0; xbar.st = xst;
    const int lo = a.ph_lo, hi = a.ph_hi;
    unsigned char* ws = a.ws;
#ifndef MK_SKIP
#define MK_SKIP 0
#endif
#define IN(k) (!((MK_SKIP >> (k)) & 1) && lo <= (k) && (k) < hi)
#ifndef MK_DUPSYNC
#define MK_DUPSYNC 0
#endif
#define SEAM(k) do { if (IN(k) && IN((k) + 1)) { if ((k) == 0) { grid.sync(); xbar = xcd_barrier_post((unsigned*)(a.ws + WS_BAR), xst); } else { xcd_barrier(xbar); if (MK_DUPSYNC) { xcd_barrier(xbar); xcd_barrier(xbar); } } } } while (0)
#ifndef MK_DUP
#define MK_DUP 0
#endif
#define DUP(k) ((MK_DUP >> (k)) & 1)
#ifndef MK_TS_A
#define MK_TS_A -1
#define MK_TS_B -1
#endif
    unsigned long long ts_a = 0, ts_b = 0;
#define STAMP(k) do { if (MK_TS_A >= 0) { const unsigned long long t_ = __builtin_amdgcn_s_memrealtime(); if ((k) == MK_TS_A) ts_a = t_; if ((k) == MK_TS_B) ts_b = t_; } } while (0)
    STAMP(0);
    if (IN(0)) { phase0(a, lds); if (DUP(0)) { __syncthreads(); phase0(a, lds); } } SEAM(0); STAMP(1);
    if (IN(1)) { phase_wcopy(a, lds); phase1(a); if (DUP(1)) phase1(a); } SEAM(1); STAMP(2);
    for (int rep = 0; rep < 1 + DUP(2); ++rep) if (IN(2)) {
        pg8::Gemm g{(const pg8::bf16_t*)((const unsigned char*)a.out + OUT_H), (const pg8::bf16_t*)((const unsigned char*)a.out + OUT_WIN), MROWS, NPAD, DM}; InOrder S; S.so.init(MROWS, 13 * 256, (int)gridDim.x, (int)blockIdx.x); S.limit = 130 * 13; S.mode = 0;
        EpiIn E{(bfu*)(ws + WS_QKVG), (bfu*)(ws + WS_Z), (bfu*)(ws + WS_QKVA), (bfu*)(ws + WS_GATES)};
        pg8::gemm_phase<EpiIn, InOrder, true, true>((PG8_LAS unsigned char*)lds_, g, S, E);
    } SEAM(2); STAMP(3);
    if (IN(3)) {
        for (int rep = 0; rep < 1 + DUP(3); ++rep) {
            { unsigned raw[12][3]; float cw[5][3][2], gpre[4];
              if ((int)blockIdx.x < NB * GH * NCH) prep_load(a, (int)blockIdx.x, raw, cw, gpre);
              for (int it = blockIdx.x; it < NB * GH * NCH; it += gridDim.x) { const int nx = it + (int)gridDim.x; prep_item(a, lds, it, nx < NB * GH * NCH ? nx : -1, raw, cw, gpre); } }
            __syncthreads();
            { const int nit = (NB * GH * NCH - (int)blockIdx.x + (int)gridDim.x - 1) / (int)gridDim.x; const int wv = __builtin_amdgcn_readfirstlane((int)threadIdx.x >> 6);
              for (int p = wv; p < 2 * nit; p += 8) prep_part2(a, lds, (int)blockIdx.x + (p >> 1) * (int)gridDim.x, p & 1); }
            __syncthreads();
        }
    } SEAM(3); STAMP(4);
    if (IN(4)) {
        constexpr int NSCAN = 64, NUB = 130 * 14;
        const bool scanner = (int)blockIdx.x < NSCAN;
        if (scanner) { scan_item(a, lds, (int)blockIdx.x); if (DUP(4)) scan_item(a, lds, (int)blockIdx.x); }
#ifndef MK_SPLIT4
#define MK_SPLIT4 0
#endif
        if (MK_SPLIT4) { xcd_barrier(xbar); STAMP(9); }
        pg8::Gemm g{(const pg8::bf16_t*)((const unsigned char*)a.out + OUT_H), (const pg8::bf16_t*)((const unsigned char*)a.out + OUT_WIN), MROWS, NPAD, DM}; InOrder S; S.mode = 1;
#ifndef MK_SCAN_UNITS
#define MK_SCAN_UNITS 0
#endif
        if (MK_SPLIT4) { S.so.init(MROWS, 14 * 256, (int)gridDim.x, (int)blockIdx.x); S.limit = NUB; }
        else if (scanner) { S.so.init(MROWS, 14 * 256, 1 << 20, NUB - NSCAN + (int)blockIdx.x); S.limit = MK_SCAN_UNITS ? NUB : 0; }
        else { S.so.init(MROWS, 14 * 256, (int)gridDim.x - NSCAN, (int)blockIdx.x - NSCAN); S.limit = MK_SCAN_UNITS ? NUB - NSCAN : NUB; }
        EpiIn E{(bfu*)(ws + WS_QKVG), (bfu*)(ws + WS_Z), (bfu*)(ws + WS_QKVA), (bfu*)(ws + WS_GATES)};
        pg8::gemm_phase<EpiIn, InOrder, true, true>((PG8_LAS unsigned char*)lds_, g, S, E);
    } SEAM(4); STAMP(5);
    if (IN(5)) { phase3a(a); phase5(a); } SEAM(5); STAMP(6);
    if (IN(6)) {
        for (int u = blockIdx.x; u < 1024; u += gridDim.x) {
            __syncthreads();
            const int bkv = u >> 8, b = bkv >> 1, kvh = bkv & 1, rem = u & 255, g4 = rem >> 6, qb = rem & 63, head = kvh * 4 + g4;
            const bfu* QKVA = (const bfu*)(ws + WS_QKVA);
            const bfu* Qp = QKVA + (size_t)(b * TOK + CTXL + qb * 256) * 1536 + head * 128;
            const bfu* Kp = (const bfu*)(ws + WS_KC) + (size_t)(b * 2 + kvh) * TOK * 128; const bfu* Vp = (const bfu*)(ws + WS_VC) + (size_t)(b * 2 + kvh) * TOK * 128;
            bfu* Zp = (bfu*)(ws + WS_Z) + (size_t)(b * TOK + CTXL + qb * 256) * 2048 + 1024 + head * 128;
            if (DUP(6)) { att::attn_dense_body<att::bf16>((const att::bf16*)Qp, (const att::bf16*)Kp, (const att::bf16*)Vp, (bfu*)nullptr, TOK, lds); __syncthreads(); }
            att::attn_dense_body<att::bf16>((const att::bf16*)Qp, (const att::bf16*)Kp, (const att::bf16*)Vp, Zp, TOK, lds);
        }
    } SEAM(6); STAMP(7);
    if (IN(7)) {
        pg8::Gemm g{(const pg8::bf16_t*)(ws + WS_Z), (const pg8::bf16_t*)(ws + WS_WOUT), NB * SEQ, DM, DM};
        const int G_ = (int)gridDim.x, c_ = (int)blockIdx.x; OutOrderN S; S.G = G_; S.vc = (G_ % 8 == 0) ? (c_ % 8) * (G_ / 8) + c_ / 8 : c_;
        EpiOutNorm E{a.in[0], (const float*)(ws + WS_MOD), a.in[15], a.out, (float*)(ws + WS_XBUF), (unsigned*)(ws + WS_PCNT), lds + 131072};
        pg8::gemm_phase<EpiOutNorm, OutOrderN, true, true>((PG8_LAS unsigned char*)lds_, g, S, E);
    }
    if (MK_TS_A >= 0 && blockIdx.x == 0) { __syncthreads(); long long v = (long long)(ts_b - ts_a) / 100; v = v < 0 ? 0 : (v > 6000 ? 6000 : v);
        for (int i = threadIdx.x; i < (int)v; i += 512) a.out[i] += 0.25f; }
#undef IN
#undef SEAM
}

extern "C" void kernel_launch(void* const* d_in, const int* in_sizes, int n_in, void* d_out, int out_size, void* d_ws, size_t ws_size, hipStream_t stream) {
    static int grid = 0;
    if (grid == 0) {
        if (n_in != 16 || out_size != NB * SEQ * DM || ws_size < WS_END) { fprintf(stderr, "kernel_launch: unexpected shapes (n_in %d out %d ws %zu need %zu)\n", n_in, out_size, ws_size, (size_t)WS_END); grid = -1; return; }
        int dev = 0, cus = 0, per_cu = 0;
        hipGetDevice(&dev); hipDeviceGetAttribute(&cus, hipDeviceAttributeMultiprocessorCount, dev);
        if (hipFuncSetAttribute((const void*)mega_fwd, hipFuncAttributeMaxDynamicSharedMemorySize, LDS_BYTES) != hipSuccess) { fprintf(stderr, "kernel_launch: hipFuncSetAttribute failed\n"); grid = -1; return; }
        if (hipOccupancyMaxActiveBlocksPerMultiprocessor(&per_cu, (const void*)mega_fwd, 512, LDS_BYTES) != hipSuccess || per_cu < 1) { fprintf(stderr, "kernel_launch: occupancy query says %d\n", per_cu); per_cu = 1; }
        (void)hipGetLastError();
        grid = cus * per_cu;
        fprintf(stderr, "kernel_launch: grid %d (cus %d x %d)\n", grid, cus, per_cu);
    }
    if (grid < 0) return;
    Args a{};
    for (int i = 0; i < 16; ++i) a.in[i] = (const float*)d_in[i];
    a.out = (float*)d_out; a.ws = (unsigned char*)d_ws;
#if MK_COOP
    a.ph_lo = 0; a.ph_hi = NPHASE;
    void* args[] = {&a};
    hipError_t e = hipLaunchCooperativeKernel((const void*)mega_fwd, dim3(grid), dim3(512), args, LDS_BYTES, stream);
    if (e != hipSuccess) fprintf(stderr, "kernel_launch: cooperative launch failed: %s (grid %d)\n", hipGetErrorString(e), grid);
#else
    for (int p = 0; p < NPHASE; ++p) { a.ph_lo = p; a.ph_hi = p + 1; hipLaunchKernelGGL(mega_fwd, dim3(grid), dim3(512), LDS_BYTES, stream, a); }
#endif
}
```
